# Optimizing an MI355X kernel written in HIP

```python
import math
import jax, jax.numpy as jnp
from jax import lax
import numpy as np

D_MODEL = 1024
BATCH = 8
SEQ = 4096
DEPTH = 2

HEAD_DIM = 64
N_HEADS = D_MODEL // HEAD_DIM
N_KV = 4
HPG = N_HEADS // N_KV
Q_WIDTH = N_HEADS * HEAD_DIM
KV_WIDTH = N_KV * HEAD_DIM
CMP_LEN = 32
CMP_STRIDE = 16
CMP_HIDDEN = 256
SLC_LEN = 64
N_SELECT = 16
NSA_WINDOW = 512
NSA_QBLK = 64
NSA_IN = Q_WIDTH + 6 * KV_WIDTH + 3 * N_HEADS
NSA_SPLITS = (Q_WIDTH, Q_WIDTH + KV_WIDTH, Q_WIDTH + 2 * KV_WIDTH, Q_WIDTH + 3 * KV_WIDTH,
              Q_WIDTH + 4 * KV_WIDTH, Q_WIDTH + 5 * KV_WIDTH, Q_WIDTH + 6 * KV_WIDTH)
SWA_WINDOW = 128
SWA_QBLK = 128
N_BUCKETS = 32
MAX_DISTANCE = 128
N_EXPERTS = 16
N_GROUPS = 4
EXPERTS_PER_GROUP = N_EXPERTS // N_GROUPS
TOP_K = 2
D_EXPERT = 256
N_A_LAYERS = max(1, DEPTH // 2)
N_B_LAYERS = DEPTH - N_A_LAYERS
ALPHA = (2.0 * DEPTH) ** 0.25
BETA = (8.0 * DEPTH) ** -0.25
LN_EPS = 1e-5
NEG = -1e30
ATTN_SCALE = HEAD_DIM ** -0.5

kernel_name = 'nsa_swa_sink_yoco_grouped_moe'


def layer_norm(x, g, b):
    xf = x.astype(jnp.float32)
    mu = xf.mean(-1, keepdims=True)
    var = jnp.mean(jnp.square(xf - mu), -1, keepdims=True)
    return ((xf - mu) * lax.rsqrt(var + LN_EPS) * g.astype(jnp.float32)
            + b.astype(jnp.float32)).astype(x.dtype)


def modulate(x, shift, scale):
    return x * (1.0 + scale[:, None, :]) + shift[:, None, :]


def rel_bucket(dist):
    max_exact = N_BUCKETS // 2
    d = jnp.maximum(dist, 0)
    large = max_exact + (jnp.log(jnp.maximum(d, 1).astype(jnp.float32) / max_exact)
                         / math.log(MAX_DISTANCE / max_exact)
                         * (N_BUCKETS - max_exact)).astype(jnp.int32)
    large = jnp.minimum(large, N_BUCKETS - 1)
    return jnp.where(d < max_exact, d, large)


def masked_softmax(logits, valid):
    p = jax.nn.softmax(jnp.where(valid, logits, NEG), axis=-1)
    return jnp.where(valid, p, 0.0)


def compress_blocks(k, pos, w1, w2):
    B, G, S, dk = k.shape
    chunks = k.reshape(B, G, S // CMP_STRIDE, CMP_STRIDE, dk)
    blocks = jnp.concatenate([chunks[:, :, :-1], chunks[:, :, 1:]], axis=3) + pos
    blocks = blocks.reshape(B, G, S // CMP_STRIDE - 1, CMP_LEN * dk)
    return jax.nn.gelu(blocks @ w1) @ w2


def band_bias(rel_table, qblk, window):
    n_k = qblk + window
    dist = jnp.arange(qblk)[:, None] + window - jnp.arange(n_k)[None, :]
    band = (dist >= 0) & (dist < window)
    bias = rel_table[rel_bucket(dist)].astype(jnp.float32)
    bias = bias.reshape(qblk, n_k, N_KV, HPG).transpose(2, 3, 0, 1)
    return dist, band, bias


def nsa_mixer(h, w_in, k_w1, k_w2, v_w1, v_w2, k_pos, v_pos, w_out, rel_table):
    B, S, _ = h.shape
    G, J, dk = N_KV, HPG, HEAD_DIM
    proj = h @ w_in
    q, kc, vc, ksl, vsl, kw, vw, gl = jnp.split(proj, NSA_SPLITS, axis=-1)
    q = q.reshape(B, S, G, J, dk).transpose(0, 2, 3, 1, 4)
    to_kv = lambda t: t.reshape(B, S, G, dk).transpose(0, 2, 1, 3)
    kc, vc, ksl, vsl, kw, vw = [to_kv(t) for t in (kc, vc, ksl, vsl, kw, vw)]
    gates = jax.nn.sigmoid(gl.astype(jnp.float32)).reshape(B, S, 3, G, J).transpose(0, 3, 4, 1, 2)

    k_cmp = compress_blocks(kc, k_pos, k_w1, k_w2)
    v_cmp = compress_blocks(vc, v_pos, v_w1, v_w2)
    n_cmp = k_cmp.shape[2]
    cmp_end = jnp.arange(n_cmp) * CMP_STRIDE + CMP_LEN - 1
    n_slc = S // SLC_LEN
    n_sel = min(N_SELECT, n_slc)
    c_start = jnp.arange(n_cmp)[:, None] * CMP_STRIDE
    s_start = jnp.arange(n_slc)[None, :] * SLC_LEN
    overlap = ((c_start < s_start + SLC_LEN) & (c_start + CMP_LEN > s_start)).astype(jnp.float32)
    k_blk = ksl.reshape(B, G, n_slc, SLC_LEN, dk)
    v_blk = vsl.reshape(B, G, n_slc, SLC_LEN, dk)
    blk_off = jnp.arange(SLC_LEN)
    b_idx = jnp.arange(B)[:, None, None, None]
    g_idx = jnp.arange(G)[None, :, None, None]
    table_g = rel_table.astype(jnp.float32).reshape(N_BUCKETS, G, J).transpose(1, 0, 2)
    jblk = jnp.arange(n_slc)
    kw_pad = jnp.pad(kw, ((0, 0), (0, 0), (NSA_WINDOW, 0), (0, 0)))
    vw_pad = jnp.pad(vw, ((0, 0), (0, 0), (NSA_WINDOW, 0), (0, 0)))
    _, win_band, win_bias = band_bias(rel_table, NSA_QBLK, NSA_WINDOW)
    n_kw = NSA_QBLK + NSA_WINDOW

    def q_block(qb):
        s0 = qb * NSA_QBLK
        tq = s0 + jnp.arange(NSA_QBLK)
        qblk = lax.dynamic_slice_in_dim(q, s0, NSA_QBLK, axis=3)

        dist_c = tq[:, None] - cmp_end[None, :]
        bias_c = rel_table[rel_bucket(dist_c)].astype(jnp.float32)
        bias_c = bias_c.reshape(NSA_QBLK, n_cmp, G, J).transpose(2, 3, 0, 1)
        lg_c = jnp.einsum('bghqd,bgnd->bghqn', qblk, k_cmp).astype(jnp.float32) * ATTN_SCALE + bias_c
        p_c = masked_softmax(lg_c, dist_c >= 0)
        o_c = jnp.einsum('bghqn,bgnd->bghqd', p_c.astype(v_cmp.dtype), v_cmp)

        imp = jnp.einsum('bghqn,nj->bgqj', p_c, overlap)
        cur = (tq // SLC_LEN)[:, None]
        forced = (jblk[None, :] == 0) | (jblk[None, :] == cur) | (jblk[None, :] == cur - 1)
        future = jblk[None, :] > cur
        imp = jnp.where(forced, 1e9, jnp.where(future, -1e9, imp))
        _, idx = lax.top_k(imp, n_sel)
        n_ks = n_sel * SLC_LEN
        k_sel = k_blk[b_idx, g_idx, idx].reshape(B, G, NSA_QBLK, n_ks, dk)
        v_sel = v_blk[b_idx, g_idx, idx].reshape(B, G, NSA_QBLK, n_ks, dk)
        kpos_s = (idx[..., None] * SLC_LEN + blk_off).reshape(B, G, NSA_QBLK, n_ks)
        dist_s = tq[None, None, :, None] - kpos_s
        bias_s = table_g[g_idx, rel_bucket(dist_s)].transpose(0, 1, 4, 2, 3)
        lg_s = jnp.einsum('bghqd,bgqkd->bghqk', qblk, k_sel).astype(jnp.float32) * ATTN_SCALE + bias_s
        p_s = masked_softmax(lg_s, (dist_s >= 0)[:, :, None])
        o_s = jnp.einsum('bghqk,bgqkd->bghqd', p_s.astype(v_sel.dtype), v_sel)

        kb = lax.dynamic_slice_in_dim(kw_pad, s0, n_kw, axis=2)
        vb = lax.dynamic_slice_in_dim(vw_pad, s0, n_kw, axis=2)
        kpos_w = s0 - NSA_WINDOW + jnp.arange(n_kw)
        valid_w = win_band & (kpos_w >= 0)[None, :]
        lg_w = jnp.einsum('bghqd,bgkd->bghqk', qblk, kb).astype(jnp.float32) * ATTN_SCALE + win_bias
        p_w = masked_softmax(lg_w, valid_w)
        o_w = jnp.einsum('bghqk,bgkd->bghqd', p_w.astype(vb.dtype), vb)

        g = lax.dynamic_slice_in_dim(gates, s0, NSA_QBLK, axis=3).astype(o_c.dtype)
        return g[..., 0:1] * o_c + g[..., 1:2] * o_s + g[..., 2:3] * o_w

    o = lax.map(q_block, jnp.arange(S // NSA_QBLK))
    o = o.transpose(1, 0, 4, 2, 3, 5).reshape(B, S, Q_WIDTH)
    return o @ w_out


def swa_sink_mixer(h, w_q, k_sh, v_sh, sinks, w_out, rel_table):
    B, S, _ = h.shape
    G, J, dk = N_KV, HPG, HEAD_DIM
    q = (h @ w_q).reshape(B, S, G, J, dk).transpose(0, 2, 3, 1, 4)
    k_pad = jnp.pad(k_sh, ((0, 0), (0, 0), (SWA_WINDOW, 0), (0, 0)))
    v_pad = jnp.pad(v_sh, ((0, 0), (0, 0), (SWA_WINDOW, 0), (0, 0)))
    _, band, bias = band_bias(rel_table, SWA_QBLK, SWA_WINDOW)
    n_k = SWA_QBLK + SWA_WINDOW
    sink = jnp.broadcast_to(sinks.astype(jnp.float32).reshape(1, G, J, 1, 1), (B, G, J, SWA_QBLK, 1))

    def q_block(qb):
        s0 = qb * SWA_QBLK
        qblk = lax.dynamic_slice_in_dim(q, s0, SWA_QBLK, axis=3)
        kb = lax.dynamic_slice_in_dim(k_pad, s0, n_k, axis=2)
        vb = lax.dynamic_slice_in_dim(v_pad, s0, n_k, axis=2)
        kpos = s0 - SWA_WINDOW + jnp.arange(n_k)
        valid = band & (kpos >= 0)[None, :]
        lg = jnp.einsum('bghqd,bgkd->bghqk', qblk, kb).astype(jnp.float32) * ATTN_SCALE + bias
        lg = jnp.where(valid, lg, NEG)
        p = jax.nn.softmax(jnp.concatenate([lg, sink], axis=-1), axis=-1)[..., :-1]
        return jnp.einsum('bghqk,bgkd->bghqd', p.astype(vb.dtype), vb)

    o = lax.map(q_block, jnp.arange(S // SWA_QBLK))
    o = o.transpose(1, 0, 4, 2, 3, 5).reshape(B, S, Q_WIDTH)
    return o @ w_out


def grouped_moe(h, router_w, router_b, w_gate, w_up, w_down):
    B, S, D = h.shape
    T = B * S
    t = h.reshape(T, D)
    s = jax.nn.sigmoid((t @ router_w).astype(jnp.float32))
    sb = s + router_b.astype(jnp.float32)
    grp_score = lax.top_k(sb.reshape(T, N_GROUPS, EXPERTS_PER_GROUP), TOP_K)[0].sum(-1)
    grp = jnp.argmax(grp_score, axis=-1)
    in_grp = (jnp.arange(N_EXPERTS) // EXPERTS_PER_GROUP)[None, :] == grp[:, None]
    _, e_idx = lax.top_k(jnp.where(in_grp, sb, -jnp.inf), TOP_K)
    s_sel = jnp.take_along_axis(s, e_idx, axis=-1)
    w = s_sel / s_sel.sum(-1, keepdims=True)
    gates = jnp.einsum('tk,tke->te', w, jax.nn.one_hot(e_idx, N_EXPERTS, dtype=jnp.float32)).astype(t.dtype)
    out = jnp.zeros_like(t)
    for e in range(N_EXPERTS):
        he = jax.nn.silu(t @ w_gate[e]) * (t @ w_up[e])
        out = out + gates[:, e:e + 1] * (he @ w_down[e])
    return out.reshape(B, S, D)


def setup_inputs(seed: int = 0) -> dict:
    key = jax.random.key(seed)
    ks = jax.random.split(key, 24)
    D = D_MODEL
    nrm = lambda k, shape, s: jax.random.normal(k, shape, jnp.float32) * s
    return {
        'x': nrm(ks[0], (BATCH, SEQ, D), 1.0),
        'c': nrm(ks[1], (BATCH, D), 1.0),
        'nsa_w_in': nrm(ks[2], (N_A_LAYERS, D, NSA_IN), D ** -0.5),
        'cmp_k_w1': nrm(ks[3], (N_A_LAYERS, CMP_LEN * HEAD_DIM, CMP_HIDDEN), (CMP_LEN * HEAD_DIM) ** -0.5),
        'cmp_k_w2': nrm(ks[4], (N_A_LAYERS, CMP_HIDDEN, HEAD_DIM), CMP_HIDDEN ** -0.5),
        'cmp_v_w1': nrm(ks[5], (N_A_LAYERS, CMP_LEN * HEAD_DIM, CMP_HIDDEN), (CMP_LEN * HEAD_DIM) ** -0.5),
        'cmp_v_w2': nrm(ks[6], (N_A_LAYERS, CMP_HIDDEN, HEAD_DIM), CMP_HIDDEN ** -0.5),
        'cmp_k_pos': nrm(ks[7], (N_A_LAYERS, CMP_LEN, HEAD_DIM), 0.1),
        'cmp_v_pos': nrm(ks[8], (N_A_LAYERS, CMP_LEN, HEAD_DIM), 0.1),
        'nsa_w_out': nrm(ks[9], (N_A_LAYERS, Q_WIDTH, D), Q_WIDTH ** -0.5 * BETA),
        'swa_w_q': nrm(ks[10], (N_B_LAYERS, D, Q_WIDTH), D ** -0.5),
        'swa_sinks': nrm(ks[11], (N_B_LAYERS, N_HEADS), 0.5),
        'swa_w_out': nrm(ks[12], (N_B_LAYERS, Q_WIDTH, D), Q_WIDTH ** -0.5 * BETA),
        'shared_w_kv': nrm(ks[13], (D, 2 * KV_WIDTH), D ** -0.5),
        'rel_bias': nrm(ks[14], (N_BUCKETS, N_HEADS), 0.5),
        'router_w': nrm(ks[15], (D, N_EXPERTS), D ** -0.5),
        'router_b': nrm(ks[16], (N_EXPERTS,), 0.01),
        'moe_w_gate': nrm(ks[17], (DEPTH, N_EXPERTS, D, D_EXPERT), D ** -0.5),
        'moe_w_up': nrm(ks[18], (DEPTH, N_EXPERTS, D, D_EXPERT), D ** -0.5),
        'moe_w_down': nrm(ks[19], (DEPTH, N_EXPERTS, D_EXPERT, D), D_EXPERT ** -0.5 * BETA),
        'ada_w': nrm(ks[20], (DEPTH, D, 6 * D), 0.1 * D ** -0.5),
        'ada_b': nrm(ks[21], (DEPTH, 6 * D), 0.02),
        'ln_g': 1.0 + nrm(ks[22], (DEPTH, 2, D), 0.02),
        'ln_b': nrm(ks[23], (DEPTH, 2, D), 0.02),
    }


def reference(x, c, nsa_w_in, cmp_k_w1, cmp_k_w2, cmp_v_w1, cmp_v_w2, cmp_k_pos, cmp_v_pos,
              nsa_w_out, swa_w_q, swa_sinks, swa_w_out, shared_w_kv, rel_bias, router_w, router_b,
              moe_w_gate, moe_w_up, moe_w_down, ada_w, ada_b, ln_g, ln_b):
    B, S, _ = x.shape
    cond = jax.nn.silu(c)
    k_sh = None
    v_sh = None
    for layer in range(DEPTH):
        ada = cond @ ada_w[layer] + ada_b[layer]
        sh_a, sc_a, g_a, sh_f, sc_f, g_f = jnp.split(ada, 6, axis=-1)
        h = modulate(x, sh_a, sc_a)
        if layer < N_A_LAYERS:
            mix = nsa_mixer(h, nsa_w_in[layer], cmp_k_w1[layer], cmp_k_w2[layer], cmp_v_w1[layer],
                            cmp_v_w2[layer], cmp_k_pos[layer], cmp_v_pos[layer], nsa_w_out[layer], rel_bias)
        else:
            if layer == N_A_LAYERS:
                kv = (x @ shared_w_kv).reshape(B, S, 2, N_KV, HEAD_DIM).transpose(2, 0, 3, 1, 4)
                k_sh, v_sh = kv[0], kv[1]
            lb = layer - N_A_LAYERS
            mix = swa_sink_mixer(h, swa_w_q[lb], k_sh, v_sh, swa_sinks[lb], swa_w_out[lb], rel_bias)
        x = layer_norm(ALPHA * x + (1.0 + g_a)[:, None, :] * mix, ln_g[layer, 0], ln_b[layer, 0])
        h = modulate(x, sh_f, sc_f)
        ffn = grouped_moe(h, router_w, router_b, moe_w_gate[layer], moe_w_up[layer], moe_w_down[layer])
        x = layer_norm(ALPHA * x + (1.0 + g_f)[:, None, :] * ffn, ln_g[layer, 1], ln_b[layer, 1])
    return x
```

```cpp
#include <hip/hip_runtime.h>
#include <cstdio>
#include <cstdint>

#ifndef MK_N_LAUNCHES
#define MK_N_LAUNCHES 1
#endif
constexpr int N_PHASES = 18;

constexpr int NB = 8, SEQ = 4096, DM = 1024, NT = NB * SEQ;
constexpr int NH = 16, NG = 4, NJ = 4, HD = 64;
constexpr int NSA_IN = 2608, NPROJ = 2816;
constexpr int NE = 16, DE = 256;
constexpr float ALPHA_F = 1.4142135623730951f;
constexpr float LN_EPS_F = 1e-5f;
constexpr float LOG2E = 1.4426950408889634f;
constexpr float QSCALE = 0.125f * LOG2E;
constexpr float NEG_BIG = -1e30f;

constexpr size_t MiB = 1u << 20;
constexpr size_t WS_CTL = 0, CTL_ZERO_BYTES = 1 * MiB;
constexpr size_t WS_ADA = 1 * MiB;
constexpr size_t WS_POSB = WS_ADA + 2 * 8 * 6144 * 4;
constexpr size_t WS_WIN = 2 * MiB;
constexpr size_t WS_CW1 = 8 * MiB;
constexpr size_t WS_WOUT0 = 10 * MiB, WS_WQ1 = 12 * MiB, WS_WKV = 14 * MiB, WS_WOUT1 = 15 * MiB;
constexpr size_t WS_WGU = 18 * MiB;
constexpr size_t WS_WD = 50 * MiB;
constexpr size_t WS_LIST = 66 * MiB;
constexpr size_t WS_TOKW = 68 * MiB;
constexpr size_t WS_TOKPOS = WS_TOKW + 512 * 1024;
constexpr size_t WS_KCMP = 69 * MiB, WS_VCMP = 70 * MiB;
constexpr size_t WS_GATE = 71 * MiB;
constexpr size_t WS_A = 80 * MiB;
constexpr size_t WS_B = 144 * MiB;
constexpr size_t WS_C = 208 * MiB;
constexpr size_t WS_UL = WS_C + 100 * MiB;
constexpr size_t WS_D = 344 * MiB;
constexpr size_t WS_END = 408 * MiB;
constexpr size_t KVT = (size_t)NB * NG * SEQ * HD;
constexpr int CW_BAR = 4096;
constexpr int CW_CNT0 = 16384, CW_CNT1 = 16384 + 64;

namespace pg8 {
#define PG8_LAS __attribute__((address_space(3)))
typedef unsigned short bf16_t;
typedef short bf16x8 __attribute__((ext_vector_type(8)));
typedef float f32x4 __attribute__((ext_vector_type(4)));
typedef unsigned u32x4 __attribute__((ext_vector_type(4)));
constexpr int BM = 256, BK = 64, HALF = 128, HTB = HALF * BK * 2  , STAGE_BYTES = 8 * HTB, NXCD = 8, WGM = 8;

__host__ __device__ __forceinline__ int lds_byte(int r, int c) { const int st = (r >> 4) * 2 + (c >> 5), rr = r & 15, cc = c & 31, ob = rr * 64 + cc * 2; return st * 1024 + (ob ^ (((ob >> 9) & 1) << 5)); }
__host__ __device__ __forceinline__ void stage_rc(int b, int& R, int& C) { const int st = b / 1024, sb = b % 1024, swz = sb ^ (((sb >> 9) & 1) << 5); R = (st >> 1) * 16 + swz / 64; C = (st & 1) * 32 + (swz % 64) / 2; }
__host__ __device__ __forceinline__ int perm32(int rho) { const int n = rho >> 4, i = rho & 15; return 8 * (i >> 2) + 4 * n + (i & 3); }

struct Unit { int pm, pn, e, lt; };
struct Gemm { const bf16_t* A; const bf16_t* Bt; int lda; int K; };

struct GridOrder {
    int nM, nN, nwg, G, c;
    __device__ void init(int nM_, int nN_, int G_, int c_) { nM = nM_; nN = nN_; nwg = nM * nN; G = G_; c = c_; }
    __device__ bool tile(int i, int& pm, int& pn) const {
        const long L = (long)i * G + c; if (L >= nwg) return false;
        int wgid = (int)L; { const int q = nwg / NXCD, r = nwg % NXCD, xcd = wgid % NXCD, off = wgid / NXCD; wgid = (xcd < r ? xcd * (q + 1) : r * (q + 1) + (xcd - r) * q) + off; }
        const int nig = WGM * nN, gid = wgid / nig, fm = gid * WGM, gsz = (nM - fm) < WGM ? (nM - fm) : WGM;
        pm = fm + ((wgid % nig) % gsz); pn = (wgid % nig) / gsz; return true;
    }
};

__device__ __forceinline__ unsigned cvt_pk_bf16(float lo, float hi) { unsigned r; asm volatile("v_cvt_pk_bf16_f32 %0, %1, %2" : "=v"(r) : "v"(lo), "v"(hi)); return r; }

template <class Epi, class Sched>
__device__ __forceinline__ void gemm_phase(PG8_LAS unsigned char* lds, const Gemm g, const Sched& S, const Epi& E) {
    const int tid = threadIdx.x, wid = __builtin_amdgcn_readfirstlane(tid >> 6), lane = tid & 63, wr = wid >> 2, wc = wid & 3, fr = lane & 15, fq = lane >> 4;
    int K = g.K; asm volatile("" : "+s"(K));
    const int nt = K / BK;
    int RA[2], CA[2]; unsigned voffB[2];
#pragma unroll
    for (int i = 0; i < 2; ++i) { int R, C; stage_rc(tid * 16 + i * 8192, R, C); const int Rb = Epi::PERM ? ((R & ~31) + perm32(R & 31)) : R;
        RA[i] = R; CA[i] = C; voffB[i] = (unsigned)(Rb * K + C) * 2u; }
    const size_t kstep = (size_t)(BK * 2);
    const size_t hstep = (size_t)HALF * K * 2;
    const unsigned ldsw = (unsigned)wid * 1024u;
    const int aoff = lds_byte(wr * 64 + fr, fq * 8), boff = lds_byte(wc * 32 + fr, fq * 8);
#define PG8_SA(b, h) (((b) * 2 + (h)) * HTB)
#define PG8_SB(b, h) ((4 + (b) * 2 + (h)) * HTB)
#define PG8_STAGE(bufoff, gbase, voff) do { _Pragma("unroll") for (int _i = 0; _i < 2; ++_i) \
        __builtin_amdgcn_global_load_lds((const unsigned*)((const char*)(gbase) + (voff)[_i]), (PG8_LAS unsigned*)(lds + (bufoff) + ldsw + _i * 8192), 16, 0, 0); } while (0)
#define PG8_AOFFS(ao, u) do { _Pragma("unroll") for (int _h = 0; _h < 2; ++_h) _Pragma("unroll") for (int _i = 0; _i < 2; ++_i) \
        (ao)[_h][_i] = (unsigned)(S.a_row((u), _h * HALF + RA[_i]) * g.lda + CA[_i]) * 2u; } while (0)
#define PG8_LDA(dst, b, h) do { _Pragma("unroll") for (int m = 0; m < 4; ++m) _Pragma("unroll") for (int k = 0; k < 2; ++k) dst[m][k] = *(const PG8_LAS bf16x8*)(lds + PG8_SA(b, h) + aoff + m * 2048 + k * 1024); } while (0)
#define PG8_LDB(dst, b, h) do { _Pragma("unroll") for (int n = 0; n < 2; ++n) _Pragma("unroll") for (int k = 0; k < 2; ++k) dst[n][k] = *(const PG8_LAS bf16x8*)(lds + PG8_SB(b, h) + boff + n * 2048 + k * 1024); } while (0)
#define PG8_MMA(ai, bj, At, Bt) do { __builtin_amdgcn_s_setprio(1); _Pragma("unroll") for (int m = 0; m < 4; ++m) _Pragma("unroll") for (int n = 0; n < 2; ++n) _Pragma("unroll") for (int k = 0; k < 2; ++k) \
        acc[ai][bj][m][n] = __builtin_amdgcn_mfma_f32_16x16x32_bf16(Bt[n][k], At[m][k], acc[ai][bj][m][n], 0, 0, 0); __builtin_amdgcn_s_setprio(0); } while (0)
#define PG8_WAIT_V(n) asm volatile("s_waitcnt vmcnt(" #n ")" ::: "memory")
#define PG8_WAIT_L(n) asm volatile("s_waitcnt lgkmcnt(" #n ")" ::: "memory")
#define PG8_BAR __builtin_amdgcn_s_barrier()
#define PG8_SCHED __builtin_amdgcn_sched_barrier(0)
    Unit cur, nxt; int ui = 0;
    if (!S.next(0, cur)) return;
    f32x4 acc[2][2][4][2];
#pragma unroll
    for (int a = 0; a < 2; ++a)
#pragma unroll
        for (int b = 0; b < 2; ++b)
#pragma unroll
            for (int m = 0; m < 4; ++m)
#pragma unroll
                for (int n = 0; n < 2; ++n) acc[a][b][m][n] = (f32x4){0.f, 0.f, 0.f, 0.f};
    bf16x8 At[4][2], B0[2][2], B1[2][2];
    const char* A0 = (const char*)g.A;
    const char* cB = (const char*)g.Bt + (size_t)S.b_row0(cur) * K * 2;
    unsigned aoc[2][2], aon[2][2];
    PG8_AOFFS(aoc, cur);
    PG8_STAGE(PG8_SB(0, 0), cB, voffB); PG8_STAGE(PG8_SB(0, 1), cB + hstep, voffB); PG8_STAGE(PG8_SA(0, 0), A0, aoc[0]); PG8_STAGE(PG8_SA(0, 1), A0, aoc[1]);
    if (wr == 1) PG8_BAR;
    PG8_WAIT_V(2); PG8_BAR;
    PG8_STAGE(PG8_SB(1, 0), cB + kstep, voffB); PG8_STAGE(PG8_SA(1, 0), A0 + kstep, aoc[0]); PG8_STAGE(PG8_SB(1, 1), cB + hstep + kstep, voffB);
    PG8_WAIT_V(6); PG8_BAR;
    for (;;) {
        const bool has_next = S.next(ui + 1, nxt);
        const char* nB = has_next ? (const char*)g.Bt + (size_t)S.b_row0(nxt) * K * 2 : cB;
        if (has_next) { PG8_AOFFS(aon, nxt); } else {
#pragma unroll
            for (int h = 0; h < 2; ++h)
#pragma unroll
                for (int i = 0; i < 2; ++i) aon[h][i] = aoc[h][i]; }
        for (int t = 0; t < nt; t += 2) {
            const bool last = (t == nt - 2);
            const char* a1 = A0 + (size_t)(t + 1) * kstep;
            const char* a2 = last ? A0 : A0 + (size_t)(t + 2) * kstep; const char* b2 = last ? nB : cB + (size_t)(t + 2) * kstep;
            const char* a3 = a2 + kstep; const char* b3 = b2 + kstep;
            unsigned ao2[2][2];
#pragma unroll
            for (int h = 0; h < 2; ++h)
#pragma unroll
                for (int i = 0; i < 2; ++i) ao2[h][i] = last ? aon[h][i] : aoc[h][i];
            PG8_LDB(B0, 0, 0); PG8_LDB(B1, 0, 1); PG8_SCHED; PG8_LDA(At, 0, 0); PG8_STAGE(PG8_SA(1, 1), a1, aoc[1]);
            PG8_WAIT_V(8); PG8_WAIT_L(0); PG8_BAR; PG8_MMA(0, 0, At, B0); PG8_MMA(0, 1, At, B1); PG8_BAR; PG8_SCHED;
            PG8_LDA(At, 0, 1); PG8_STAGE(PG8_SB(0, 0), b2, voffB); PG8_STAGE(PG8_SB(0, 1), b2 + hstep, voffB); PG8_STAGE(PG8_SA(0, 0), a2, ao2[0]);
            PG8_WAIT_V(8); PG8_WAIT_L(0); PG8_BAR; PG8_MMA(1, 0, At, B0); PG8_MMA(1, 1, At, B1); PG8_BAR; PG8_SCHED;
            PG8_LDB(B0, 1, 0); PG8_LDB(B1, 1, 1); PG8_SCHED; PG8_LDA(At, 1, 0); PG8_STAGE(PG8_SA(0, 1), a2, ao2[1]);
            PG8_WAIT_V(8); PG8_WAIT_L(0); PG8_BAR; PG8_MMA(0, 0, At, B0); PG8_MMA(0, 1, At, B1); PG8_BAR; PG8_SCHED;
            PG8_LDA(At, 1, 1); PG8_STAGE(PG8_SB(1, 0), b3, voffB); PG8_STAGE(PG8_SB(1, 1), b3 + hstep, voffB); PG8_STAGE(PG8_SA(1, 0), a3, ao2[0]);
            PG8_WAIT_V(8); PG8_WAIT_L(0); PG8_BAR; PG8_MMA(1, 0, At, B0); PG8_MMA(1, 1, At, B1); PG8_BAR; PG8_SCHED;
        }
        if (wr == 0) PG8_BAR;
        E(acc, cur, wr, wc, fr, fq);
        if (!has_next) break;
#pragma unroll
        for (int a = 0; a < 2; ++a)
#pragma unroll
            for (int b = 0; b < 2; ++b)
#pragma unroll
                for (int m = 0; m < 4; ++m)
#pragma unroll
                    for (int n = 0; n < 2; ++n) acc[a][b][m][n] = (f32x4){0.f, 0.f, 0.f, 0.f};
        cur = nxt; cB = nB; ++ui;
#pragma unroll
        for (int h = 0; h < 2; ++h)
#pragma unroll
            for (int i = 0; i < 2; ++i) aoc[h][i] = aon[h][i];
        if (wr == 1) PG8_BAR;
    }
    PG8_WAIT_V(0);
    PG8_BAR;
#undef PG8_SA
#undef PG8_SB
#undef PG8_STAGE
#undef PG8_AOFFS
#undef PG8_LDA
#undef PG8_LDB
#undef PG8_MMA
#undef PG8_WAIT_V
#undef PG8_WAIT_L
#undef PG8_BAR
#undef PG8_SCHED
}
}

#define GAS __attribute__((address_space(1)))
#define LAS __attribute__((address_space(3)))
typedef unsigned short bf16;
typedef unsigned v4u __attribute__((ext_vector_type(4)));
typedef float f32x4 __attribute__((ext_vector_type(4)));
typedef short bf16x8 __attribute__((ext_vector_type(8)));
typedef GAS unsigned gu32;
typedef GAS unsigned long long gu64;
#define RLX_AGENT __ATOMIC_RELAXED, __HIP_MEMORY_SCOPE_AGENT
#define LDS_WAIT() asm volatile("s_waitcnt lgkmcnt(0)" ::: "memory")
#define VM_WAIT() asm volatile("s_waitcnt vmcnt(0)" ::: "memory")
__device__ __forceinline__ unsigned long long rt() { return __builtin_amdgcn_s_memrealtime(); }
__device__ __forceinline__ unsigned f2bf(float f) { unsigned u = __builtin_bit_cast(unsigned, f); return (u + 0x7fffu + ((u >> 16) & 1u)) >> 16; }
__device__ __forceinline__ unsigned pk2(float lo, float hi) { return f2bf(lo) | (f2bf(hi) << 16); }

#define XB_TMO      128
#define XB_XCNT(j)  (256  + 64 * (j))
#define XB_XSUB(j)  (1280 + 64 * (j))
#define XB_XGEN(j)  (2304 + 64 * (j))
#define XB_TOP      3328
#define XB_TOPGEN   3392
#define XCD_BAR_WORDS 3456
#define XB_SPIN_CAP (1u << 18)

__device__ __forceinline__ unsigned xb_ld(unsigned* p)              { return __hip_atomic_load(p, __ATOMIC_RELAXED, __HIP_MEMORY_SCOPE_AGENT); }
__device__ __forceinline__ unsigned xb_add(unsigned* p, unsigned v) { return __hip_atomic_fetch_add(p, v, __ATOMIC_RELAXED, __HIP_MEMORY_SCOPE_AGENT); }
__device__ __forceinline__ unsigned xb_xcc_id() { return (unsigned)__builtin_amdgcn_s_getreg((3 << 11) | 20) & 0xFu; }
#define XB_SPIN(cond, bar) do { unsigned _sp = 0; while (cond) { __builtin_amdgcn_s_sleep(1); \
    if ((++_sp & 255u) == 0u) { if (xb_ld(&(bar)[XB_TMO])) break; if (_sp > XB_SPIN_CAP) { atomicAdd(&(bar)[XB_TMO], 1u); break; } } } } while (0)

struct XcdBarrier {
    unsigned* bar; unsigned x;
    volatile LAS unsigned* st;
};

__device__ __forceinline__ XcdBarrier xcd_barrier_post(unsigned* bar, volatile LAS unsigned* st) {
    XcdBarrier b; b.bar = bar; b.x = xb_xcc_id(); b.st = st;
    if (threadIdx.x == 0) (void)xb_add(&bar[XB_XCNT(b.x)], 1u);
    return b;
}
__device__ __forceinline__ void xcd_barrier_complete(unsigned* bar, unsigned x, unsigned& nloc, unsigned& nx) {
    const unsigned G = gridDim.x * gridDim.y * gridDim.z;
    unsigned sum, cnt, mine, sp = 0u;
    for (;;) {
        sum = 0u; cnt = 0u; mine = 0u;
#pragma unroll
        for (unsigned j = 0; j < 16; ++j) { const unsigned c = xb_ld(&bar[XB_XCNT(j)]); sum += c; cnt += (c > 0u) ? 1u : 0u; mine = (j == x) ? c : mine; }
        if (sum == G) break;
        __builtin_amdgcn_s_sleep(1);
        if ((++sp & 255u) == 0u) { if (xb_ld(&bar[XB_TMO])) break; if (sp > XB_SPIN_CAP) { atomicAdd(&bar[XB_TMO], 1u); break; } }
    }
    nloc = mine > 0u ? mine : 1u; nx = cnt > 0u ? cnt : 1u;
}

__device__ __forceinline__ void xcd_barrier(const XcdBarrier& b) {
    asm volatile("s_waitcnt vmcnt(0)" ::: "memory");
    __syncthreads();
    if (threadIdx.x == 0) {
        unsigned* bar = b.bar;
        __builtin_amdgcn_s_waitcnt(0);
        unsigned nloc = b.st[0], nx = b.st[1];
        if (nloc == 0u) { xcd_barrier_complete(bar, b.x, nloc, nx); b.st[0] = nloc; b.st[1] = nx; }
        const unsigned old = xb_add(&bar[XB_XSUB(b.x)], 1u);
        const unsigned gen = old / nloc;
        if (old + 1u == (gen + 1u) * nloc) {
            __builtin_amdgcn_fence(__ATOMIC_RELEASE, "agent");
            asm volatile("s_waitcnt vmcnt(0)" ::: "memory");
            const unsigned og = xb_add(&bar[XB_TOP], 1u);
            const unsigned tg = og / nx;
            if (og + 1u == (tg + 1u) * nx) xb_add(&bar[XB_TOPGEN], 1u);
            else XB_SPIN(xb_ld(&bar[XB_TOPGEN]) == tg, bar);
            __builtin_amdgcn_fence(__ATOMIC_ACQUIRE, "agent");
            xb_add(&bar[XB_XGEN(b.x)], 1u);
            asm volatile("s_waitcnt vmcnt(0)" ::: "memory");
        } else {
            XB_SPIN(xb_ld(&bar[XB_XGEN(b.x)]) == gen, bar);
            __builtin_amdgcn_fence(__ATOMIC_ACQUIRE, "agent");
            asm volatile("s_waitcnt vmcnt(0)" ::: "memory");
        }
    }
    __syncthreads();
}
constexpr int NWAVES = 8;
constexpr int RING_OFF = 0, RING_BYTES = 131072;
constexpr int MISC_OFF = RING_BYTES;
constexpr int LDS_BYTES = 147456;
typedef float f32x2 __attribute__((ext_vector_type(2)));
typedef unsigned u32x2 __attribute__((ext_vector_type(2)));

__device__ __forceinline__ float wave_sum(float v) {
#pragma unroll
    for (int o = 1; o < 64; o <<= 1) v += __shfl_xor(v, o);
    return v;
}
__device__ __forceinline__ float sigmoidf_(float x) { return 1.0f / (1.0f + __expf(-x)); }
__device__ __forceinline__ float siluf_(float x) { return x / (1.0f + __expf(-x)); }
__device__ __forceinline__ float gelu_tanh(float x) { const float u = 0.7978845608028654f * (x + 0.044715f * x * x * x); const float e = __expf(2.0f * u); const float th = 1.0f - 2.0f / (e + 1.0f); return 0.5f * x * (1.0f + th); }

__device__ __forceinline__ void tr_item(const float* W, int ldw, int k0, int n0, int nvalid, bf16* dst, int dld, int drow0, LAS float* scr, int lane) {
    const int nn = lane & 31;
#pragma unroll 8
    for (int i = 0; i < 32; ++i) { const int kk = 2 * i + (lane >> 5); scr[kk * 33 + nn] = (nn < nvalid) ? W[(size_t)(k0 + kk) * ldw + n0 + nn] : 0.f; }
    LDS_WAIT(); asm volatile("" ::: "memory");
    const int c = lane & 7;
#pragma unroll
    for (int j = 0; j < 4; ++j) { const int n = (lane >> 3) + 8 * j; const LAS float* s = scr + (8 * c) * 33 + n;
        v4u o; o.x = pk2(s[0 * 33], s[1 * 33]); o.y = pk2(s[2 * 33], s[3 * 33]); o.z = pk2(s[4 * 33], s[5 * 33]); o.w = pk2(s[6 * 33], s[7 * 33]);
        if (n < nvalid) *(GAS v4u*)(dst + (size_t)(drow0 + n) * dld + k0 + 8 * c) = o; }
    LDS_WAIT(); asm volatile("" ::: "memory");
}
struct P0Args { const float *c, *w_in, *ck_w1, *cv_w1, *ck_pos, *cv_pos, *w_out0, *w_q1, *w_kv, *w_out1, *moe_g, *moe_u, *moe_d, *ada_w, *ada_b; unsigned char* ws; };
__device__ __forceinline__ void p0_transposes(const P0Args& a, LAS unsigned char* lds, int gw, int ngw, int wave, int lane) {
    LAS float* scr = (LAS float*)(lds + 49152 + wave * 8704);
    constexpr int I_WIN = 16 * 82, I_CW = 512, I_SQ = 512, I_KV = 256, I_MOE = 4096;
    constexpr int NITEMS = I_WIN + I_CW + 3 * I_SQ + I_KV + 3 * I_MOE;
    unsigned char* ws = a.ws;
    for (int it = gw; it < NITEMS; it += ngw) {
        int r = it;
        if (r < I_WIN) { const int kb = r / 82, nb = r % 82; const int n0 = nb * 32; const int nv = (NSA_IN - n0) < 32 ? (NSA_IN - n0) : 32;
            tr_item(a.w_in, NSA_IN, kb * 64, n0, nv, (bf16*)(ws + WS_WIN), 1024, n0, scr, lane); continue; } r -= I_WIN;
        if (r < I_CW) { const int tz = r >> 8, hf = (r >> 7) & 1, q = r & 127, kb = q >> 3, nb = q & 7;
            const float* W = (tz ? a.cv_w1 : a.ck_w1) + (size_t)hf * 1024 * 256;
            tr_item(W, 256, kb * 64, nb * 32, 32, (bf16*)(ws + WS_CW1) + (size_t)tz * 512 * 1024, 1024, hf * 256 + nb * 32, scr, lane); continue; } r -= I_CW;
        if (r < I_SQ) { tr_item(a.w_out0, 1024, (r >> 5) * 64, (r & 31) * 32, 32, (bf16*)(ws + WS_WOUT0), 1024, (r & 31) * 32, scr, lane); continue; } r -= I_SQ;
        if (r < I_SQ) { tr_item(a.w_q1, 1024, (r >> 5) * 64, (r & 31) * 32, 32, (bf16*)(ws + WS_WQ1), 1024, (r & 31) * 32, scr, lane); continue; } r -= I_SQ;
        if (r < I_KV) { tr_item(a.w_kv, 512, (r >> 4) * 64, (r & 15) * 32, 32, (bf16*)(ws + WS_WKV), 1024, (r & 15) * 32, scr, lane); continue; } r -= I_KV;
        if (r < I_SQ) { tr_item(a.w_out1, 1024, (r >> 5) * 64, (r & 31) * 32, 32, (bf16*)(ws + WS_WOUT1), 1024, (r & 31) * 32, scr, lane); continue; } r -= I_SQ;
        if (r < 2 * I_MOE) { const int up = r >= I_MOE; const int q = up ? r - I_MOE : r; const int le = q >> 7, w = q & 127, kb = w >> 3, nb = w & 7; const int n0 = nb * 32;
            const float* W = (up ? a.moe_u : a.moe_g) + (size_t)le * 1024 * 256;
            tr_item(W, 256, kb * 64, n0, 32, (bf16*)(ws + WS_WGU) + (size_t)le * 512 * 1024, 1024, (n0 >> 7) * 256 + (up ? 128 : 0) + (n0 & 127), scr, lane); continue; } r -= 2 * I_MOE;
        { const int le = r >> 7, w = r & 127, kb = w >> 5, nb = w & 31;
            tr_item(a.moe_d + (size_t)le * 256 * 1024, 1024, kb * 64, nb * 32, 32, (bf16*)(ws + WS_WD) + (size_t)le * 1024 * 256, 256, nb * 32, scr, lane); }
    }
}
__device__ __forceinline__ void p0_small(const P0Args& a, LAS unsigned char* lds, int blk, int nblk, int tid) {
    LAS float* cond = (LAS float*)lds;
    LAS float* part = (LAS float*)(lds + 32768);
    const int col = tid & 63, ks = tid >> 6;
    for (int u = blk; u < 200 + 26; u += nblk) {
        if (u < 192) {
            for (int i = tid; i < 8192; i += 512) cond[i] = siluf_(a.c[i]);
            __syncthreads();
            const int layer = u / 96, c0 = (u % 96) * 64;
            const float* W = a.ada_w + (size_t)layer * 1024 * 6144 + c0 + col;
            float acc[8];
#pragma unroll
            for (int b = 0; b < 8; ++b) acc[b] = 0.f;
#pragma unroll 8
            for (int k = ks * 128; k < ks * 128 + 128; ++k) { const float w = W[(size_t)k * 6144];
#pragma unroll
                for (int b = 0; b < 8; ++b) acc[b] += cond[b * 1024 + k] * w; }
#pragma unroll
            for (int b = 0; b < 8; ++b) part[(ks * 8 + b) * 64 + col] = acc[b];
            __syncthreads();
            { const int b = tid >> 6; float s = 0.f;
#pragma unroll
              for (int k2 = 0; k2 < 8; ++k2) s += part[(k2 * 8 + b) * 64 + col];
              ((float*)(a.ws + WS_ADA))[(size_t)(layer * 8 + b) * 6144 + c0 + col] = s + a.ada_b[layer * 6144 + c0 + col]; }
            __syncthreads();
        } else if (u < 200) {
            const int tz = (u - 192) >> 2, c0 = ((u - 192) & 3) * 64;
            const float* W = (tz ? a.cv_w1 : a.ck_w1) + c0 + col; const float* pos = tz ? a.cv_pos : a.ck_pos;
            float acc = 0.f;
#pragma unroll 8
            for (int k = ks * 256; k < ks * 256 + 256; ++k) acc += pos[k] * W[(size_t)k * 256];
            part[ks * 64 + col] = acc;
            __syncthreads();
            if (tid < 64) { float s = 0.f;
#pragma unroll
                for (int k2 = 0; k2 < 8; ++k2) s += part[k2 * 64 + tid];
                ((float*)(a.ws + WS_POSB))[tz * 256 + c0 + tid] = s; }
            __syncthreads();
        } else {
            const int sl = u - 200; GAS v4u* p = (GAS v4u*)(a.ws + WS_WIN + (size_t)NSA_IN * 2048) + sl * 1024;
            for (int i = tid; i < 1024; i += 512) p[i] = (v4u){0u, 0u, 0u, 0u};
        }
    }
}

struct RowVec { f32x4 v[4]; };
__device__ __forceinline__ RowVec ld_row_f32(const float* p, int lane) { RowVec r; const GAS f32x4* q = (const GAS f32x4*)p + lane;
#pragma unroll
    for (int j = 0; j < 4; ++j) r.v[j] = q[64 * j]; return r; }
__device__ __forceinline__ void st_row_f32(float* p, int lane, const RowVec& r) { GAS f32x4* q = (GAS f32x4*)p + lane;
#pragma unroll
    for (int j = 0; j < 4; ++j) q[64 * j] = r.v[j]; }
__device__ __forceinline__ RowVec ld_row_bf16(const bf16* p, int lane) { RowVec r; const GAS u32x2* q = (const GAS u32x2*)p + lane;
#pragma unroll
    for (int j = 0; j < 4; ++j) { const u32x2 w = q[64 * j]; r.v[j] = (f32x4){__uint_as_float(w.x << 16), __uint_as_float(w.x & 0xffff0000u), __uint_as_float(w.y << 16), __uint_as_float(w.y & 0xffff0000u)}; } return r; }
__device__ __forceinline__ void st_row_bf16(bf16* p, int lane, const RowVec& r) { GAS u32x2* q = (GAS u32x2*)p + lane;
#pragma unroll
    for (int j = 0; j < 4; ++j) { u32x2 w; w.x = pk2(r.v[j].x, r.v[j].y); w.y = pk2(r.v[j].z, r.v[j].w); q[64 * j] = w; } }
__device__ __forceinline__ RowVec layer_norm_row(const RowVec& in, const RowVec& g, const RowVec& b) {
    float s = 0.f;
#pragma unroll
    for (int j = 0; j < 4; ++j) s += (in.v[j].x + in.v[j].y) + (in.v[j].z + in.v[j].w);
    const float mean = wave_sum(s) * (1.f / DM); float s2 = 0.f; RowVec d;
#pragma unroll
    for (int j = 0; j < 4; ++j) { d.v[j] = in.v[j] - mean; s2 += (d.v[j].x * d.v[j].x + d.v[j].y * d.v[j].y) + (d.v[j].z * d.v[j].z + d.v[j].w * d.v[j].w); }
    const float rstd = 1.f / sqrtf(wave_sum(s2) * (1.f / DM) + LN_EPS_F);
#pragma unroll
    for (int j = 0; j < 4; ++j) d.v[j] = d.v[j] * rstd * g.v[j] + b.v[j];
    return d;
}
__device__ __forceinline__ const float* ada_vec(const unsigned char* ws, int layer, int b, int k) { return (const float*)(ws + WS_ADA) + (size_t)(layer * 8 + b) * 6144 + k * 1024; }

__device__ __forceinline__ void p_modulate(const float* x, unsigned char* ws, int layer, bf16* hb, int gw, int ngw, int lane) {
    const int rpw = NT / ngw;
    const int r0 = gw * rpw, b = r0 >> 12;
    const RowVec sh = ld_row_f32(ada_vec(ws, layer, b, 0), lane), sc = ld_row_f32(ada_vec(ws, layer, b, 1), lane);
    for (int m = r0; m < r0 + rpw; ++m) { RowVec v = ld_row_f32(x + (size_t)m * DM, lane);
#pragma unroll
        for (int j = 0; j < 4; ++j) v.v[j] = v.v[j] * (1.0f + sc.v[j]) + sh.v[j];
        st_row_bf16(hb + (size_t)m * DM, lane, v); }
}

struct LnRouterArgs { const float* xin; float* xout; const bf16* mix; bf16* h2; const float* ln_g; const float* ln_b; const float* router_w; const float* router_b; unsigned char* ws; int layer; unsigned* cnt; };
__device__ __forceinline__ void p_ln_router(const LnRouterArgs& a, LAS unsigned char* lds, int blk, int nblk, int tid) {
    typedef float f32x4v __attribute__((ext_vector_type(4)));
    const int lane = tid & 63, wave = __builtin_amdgcn_readfirstlane(tid >> 6);
    LAS float* Tt = (LAS float*)lds;
    LAS float* Pp = (LAS float*)(lds + 66048);
    LAS float* Ss = (LAS float*)(lds + 66048 + 8192);
    LAS unsigned* tokE = (LAS unsigned*)(lds + 66048 + 8192 + 1024);
    LAS unsigned* lcnt = tokE + 256;
    LAS unsigned* lbase = lcnt + 16;
    const int rows_per_blk = NT / nblk;
    const int row0 = blk * rows_per_blk, b = row0 >> 12;
    if (tid < 16) lcnt[tid] = 0u;
    float wreg[32];
#pragma unroll
    for (int i = 0; i < 32; ++i) wreg[i] = a.router_w[(size_t)(128 * wave + 4 * i + (lane >> 4)) * 16 + (lane & 15)];
    const RowVec ga = ld_row_f32(ada_vec(a.ws, a.layer, b, 2), lane), shf = ld_row_f32(ada_vec(a.ws, a.layer, b, 3), lane), scf = ld_row_f32(ada_vec(a.ws, a.layer, b, 4), lane);
    const RowVec lg = ld_row_f32(a.ln_g, lane), lb = ld_row_f32(a.ln_b, lane);
    float* tokw = (float*)(a.ws + WS_TOKW);
    for (int grp = 0; grp < rows_per_blk / 16; ++grp) {
        const int g0 = row0 + grp * 16;
#pragma unroll
        for (int rr = 0; rr < 2; ++rr) { const int lr = 2 * wave + rr; const size_t m = (size_t)(g0 + lr);
            RowVec xv = ld_row_f32(a.xin + m * DM, lane); const RowVec mv = ld_row_bf16(a.mix + m * DM, lane);
#pragma unroll
            for (int j = 0; j < 4; ++j) xv.v[j] = ALPHA_F * xv.v[j] + (1.0f + ga.v[j]) * mv.v[j];
            RowVec y = layer_norm_row(xv, lg, lb);
            st_row_f32(a.xout + m * DM, lane, y);
#pragma unroll
            for (int j = 0; j < 4; ++j) y.v[j] = y.v[j] * (1.0f + scf.v[j]) + shf.v[j];
            st_row_bf16(a.h2 + m * DM, lane, y);
#pragma unroll
            for (int j = 0; j < 4; ++j) *(LAS f32x4v*)(Tt + lr * 1028 + 4 * lane + 256 * j) = y.v[j];
        }
        __syncthreads();
        { f32x4v acc = {0.f, 0.f, 0.f, 0.f}; const LAS float* ap = Tt + (lane & 15) * 1028 + 128 * wave + (lane >> 4);
#pragma unroll
          for (int i = 0; i < 32; ++i) acc = __builtin_amdgcn_mfma_f32_16x16x4f32(ap[4 * i], wreg[i], acc, 0, 0, 0);
#pragma unroll
          for (int r = 0; r < 4; ++r) Pp[(wave * 16 + 4 * (lane >> 4) + r) * 16 + (lane & 15)] = acc[r]; }
        __syncthreads();
        if (tid < 256) { float s = 0.f;
#pragma unroll
            for (int w = 0; w < 8; ++w) s += Pp[w * 256 + tid];
            Ss[tid] = sigmoidf_(s); }
        __syncthreads();
        if (tid < 16) {
            float ba = -INFINITY, bb = 0.f, bsa = 0.f, bsb = 0.f, best = -INFINITY; int bia = 0, bib = 0;
#pragma unroll
            for (int gi = 0; gi < 4; ++gi) { float va = -INFINITY, vb = -INFINITY, sa = 0.f, sb = 0.f; int ia = 0, ib = 0;
#pragma unroll
                for (int q = 0; q < 4; ++q) { const int e = 4 * gi + q; const float s = Ss[tid * 16 + e]; const float v = s + a.router_b[e];
                    if (v > va) { vb = va; ib = ia; sb = sa; va = v; ia = e; sa = s; } else if (v > vb) { vb = v; ib = e; sb = s; } }
                const float gs = va + vb;
                if (gs > best) { best = gs; ba = va; bb = vb; bia = ia; bib = ib; bsa = sa; bsb = sb; } }
            (void)ba; (void)bb;
            const float inv = 1.0f / (bsa + bsb); const int m = g0 + tid;
            tokw[(size_t)m * 2 + 0] = bsa * inv; tokw[(size_t)m * 2 + 1] = bsb * inv;
            const unsigned p0 = atomicAdd((unsigned*)&lcnt[bia], 1u), p1 = atomicAdd((unsigned*)&lcnt[bib], 1u);
            tokE[(grp * 16 + tid) * 2 + 0] = (unsigned)bia | (p0 << 8); tokE[(grp * 16 + tid) * 2 + 1] = (unsigned)bib | (p1 << 8);
        }
        __syncthreads();
    }
    if (tid < 16) lbase[tid] = __hip_atomic_fetch_add(a.cnt + tid, lcnt[tid], __ATOMIC_RELAXED, __HIP_MEMORY_SCOPE_AGENT);
    __syncthreads();
    if (tid < 2 * rows_per_blk) { const unsigned en = tokE[tid]; const unsigned e = en & 255u, lp = en >> 8;
        const unsigned tk = (unsigned)(row0 + (tid >> 1)) * 2u + (unsigned)(tid & 1);
        ((unsigned*)(a.ws + WS_LIST))[(size_t)e * NT + lbase[e] + lp] = tk;
        ((unsigned*)(a.ws + WS_TOKPOS))[tk] = e | ((lbase[e] + lp) << 8); }
    __syncthreads();
}

__device__ __forceinline__ void p_ln_ffn(float* xio, const bf16* y, const float* ln_g_, const float* ln_b_, unsigned char* ws, int layer, bool prep, bf16* xb, bf16* hb, const unsigned* cnt, LAS unsigned char* lds, int gw, int ngw, int tid) {
    const int lane = tid & 63;
    LAS int* tb = (LAS int*)lds;
    if (tid < 16) { int base = 0; for (int e = 0; e < tid; ++e) base += ((int)cnt[e] + 255) >> 8; tb[tid] = base; }
    __syncthreads();
    const int rpw = NT / ngw; const int r0 = gw * rpw, b = r0 >> 12;
    const RowVec gf = ld_row_f32(ada_vec(ws, layer, b, 5), lane), lg = ld_row_f32(ln_g_, lane), lb = ld_row_f32(ln_b_, lane);
    RowVec sh, sc;
    if (prep) { sh = ld_row_f32(ada_vec(ws, layer + 1, b, 0), lane); sc = ld_row_f32(ada_vec(ws, layer + 1, b, 1), lane); }
    const unsigned* tokpos = (const unsigned*)(ws + WS_TOKPOS); const float* tokw_ = (const float*)(ws + WS_TOKW);
    for (int m = r0; m < r0 + rpw; ++m) {
        const unsigned t0 = __builtin_amdgcn_readfirstlane(tokpos[2 * m]), t1 = __builtin_amdgcn_readfirstlane(tokpos[2 * m + 1]);
        const float w0 = tokw_[2 * m], w1 = tokw_[2 * m + 1];
        const size_t y0 = (size_t)tb[t0 & 255u] * 256 + (t0 >> 8), y1 = (size_t)tb[t1 & 255u] * 256 + (t1 >> 8);
        RowVec xv = ld_row_f32(xio + (size_t)m * DM, lane); const RowVec s0 = ld_row_bf16(y + y0 * DM, lane), s1 = ld_row_bf16(y + y1 * DM, lane);
#pragma unroll
        for (int j = 0; j < 4; ++j) xv.v[j] = ALPHA_F * xv.v[j] + (1.0f + gf.v[j]) * (w0 * s0.v[j] + w1 * s1.v[j]);
        RowVec yv = layer_norm_row(xv, lg, lb);
        st_row_f32(xio + (size_t)m * DM, lane, yv);
        if (prep) { st_row_bf16(xb + (size_t)m * DM, lane, yv);
#pragma unroll
            for (int j = 0; j < 4; ++j) yv.v[j] = yv.v[j] * (1.0f + sc.v[j]) + sh.v[j];
            st_row_bf16(hb + (size_t)m * DM, lane, yv); }
    }
    __syncthreads();
}

__device__ __forceinline__ void p_cmp_tail(const float* w2k, const float* w2v, unsigned char* ws, LAS unsigned char* lds, int blk, int nblk, int tid) {
    typedef float f32x4v __attribute__((ext_vector_type(4)));
    LAS float* W2 = (LAS float*)lds;
    LAS float* Hd = (LAS float*)(lds + 65536);
    const float* UL = (const float*)(ws + WS_UL);
    for (int u = blk; u < 512; u += nblk) {
        const int tz = u >> 8, bg = (u >> 3) & 31, ch = u & 7;
        const float* w2 = tz ? w2v : w2k; const float* posb = (const float*)(ws + WS_POSB) + tz * 256;
        for (int i = tid; i < 4096; i += 512) *(LAS f32x4v*)(W2 + 4 * i) = *(const GAS f32x4v*)(w2 + 4 * i);
        for (int i = tid; i < 32 * 64; i += 512) { const int n = i >> 6, c4 = (i & 63) * 4; const int nn = ch * 32 + n; const size_t R = (size_t)tz * 8192 + bg * 256 + nn;
            f32x4v h = {0.f, 0.f, 0.f, 0.f};
            if (nn < 255) { const f32x4v uu = *(const GAS f32x4v*)(UL + R * 512 + c4), ll = *(const GAS f32x4v*)(UL + (R + 1) * 512 + 256 + c4), pb = *(const GAS f32x4v*)(posb + c4);
                h.x = gelu_tanh(uu.x + ll.x + pb.x); h.y = gelu_tanh(uu.y + ll.y + pb.y); h.z = gelu_tanh(uu.z + ll.z + pb.z); h.w = gelu_tanh(uu.w + ll.w + pb.w); }
            *(LAS f32x4v*)(Hd + n * 260 + c4) = h; }
        __syncthreads();
        { const int n = tid >> 4, dq = tid & 15; f32x4v acc = {0.f, 0.f, 0.f, 0.f};
#pragma unroll 8
          for (int c = 0; c < 256; ++c) { const float h = Hd[n * 260 + c]; const f32x4v w = *(const LAS f32x4v*)(W2 + c * 64 + 4 * dq); acc += h * w; }
          bf16* dst = (bf16*)(ws + (tz ? WS_VCMP : WS_KCMP)) + ((size_t)bg * 256 + ch * 32 + n) * 64 + 4 * dq;
          u32x2 o; o.x = pk2(acc.x, acc.y); o.y = pk2(acc.z, acc.w); *(GAS u32x2*)dst = o; }
        __syncthreads();
    }
}

namespace att {
typedef float f32x16 __attribute__((ext_vector_type(16)));
typedef short s16x4 __attribute__((ext_vector_type(4)));
constexpr int KSTR = 144;
constexpr int TILE_B = 64 * KSTR;
constexpr int L_K0 = 0, L_V0 = 2 * TILE_B, L_LUT = 4 * TILE_B, L_P4 = L_LUT + 2112, L_P3 = L_P4 + 16384, L_SEL = L_P3 + 16384, L_UNI = L_SEL + 512, L_NEXT = L_UNI + 64, L_END = L_NEXT + 16;
static_assert(L_END <= RING_BYTES, "attention LDS");
__device__ const unsigned char BUCKET[129] = {0, 1, 2, 3, 4, 5, 6, 7, 8, 9, 10, 11, 12, 13, 14, 15, 16, 16, 16, 17, 17, 18, 18, 18, 19, 19, 19, 20, 20, 20, 20, 21, 21, 21, 21, 22, 22, 22, 22, 22, 23, 23, 23, 23, 23, 23, 24, 24, 24, 24, 24, 24, 25, 25, 25, 25, 25, 25, 25, 26, 26, 26, 26, 26, 26, 26, 26, 27, 27, 27, 27, 27, 27, 27, 27, 27, 27, 28, 28, 28, 28, 28, 28, 28, 28, 28, 28, 29, 29, 29, 29, 29, 29, 29, 29, 29, 29, 29, 29, 30, 30, 30, 30, 30, 30, 30, 30, 30, 30, 30, 30, 30, 30, 31, 31, 31, 31, 31, 31, 31, 31, 31, 31, 31, 31, 31, 31, 31, 31};
__device__ __forceinline__ int crow(int r, int hi) { return (r & 3) + 8 * (r >> 2) + 4 * hi; }
__device__ __forceinline__ int med3i(int a, int lo, int hi) { return a < lo ? lo : (a > hi ? hi : a); }
__device__ __forceinline__ s16x4 vtr(const LAS unsigned char* p) { return __builtin_bit_cast(s16x4, __builtin_amdgcn_ds_read_tr16_b64_v4i16((LAS s16x4*)p)); }
__device__ __forceinline__ unsigned cvtpk(float lo, float hi) { return pk2(lo, hi); }

struct TileRegs { v4u k, v; };
__device__ __forceinline__ void tile_load(TileRegs& t, const bf16* gK, const bf16* gV, int tid, bool withV) {
    t.k = *(const GAS v4u*)(gK + tid * 8); if (withV) t.v = *(const GAS v4u*)(gV + tid * 8);
}
__device__ __forceinline__ void tile_store(const TileRegs& t, LAS unsigned char* lds, int buf, int tid, bool withV) {
    const int off = (tid >> 3) * KSTR + (tid & 7) * 16;
    *(LAS v4u*)(lds + L_K0 + buf * TILE_B + off) = t.k; if (withV) *(LAS v4u*)(lds + L_V0 + buf * TILE_B + off) = t.v;
}
__device__ __forceinline__ void qk_tile(f32x16& p0, f32x16& p1, const LAS unsigned char* Ks, const bf16x8 (&qr)[4], int r32, int hi) {
    p0 = (f32x16){}; p1 = (f32x16){};
    const LAS unsigned char* kp = Ks + r32 * KSTR + hi * 16;
#pragma unroll
    for (int d0 = 0; d0 < 4; ++d0) { const bf16x8 a0 = *(const LAS bf16x8*)(kp + d0 * 32), a1 = *(const LAS bf16x8*)(kp + 32 * KSTR + d0 * 32);
        p0 = __builtin_amdgcn_mfma_f32_32x32x16_bf16(a0, qr[d0], p0, 0, 0, 0); p1 = __builtin_amdgcn_mfma_f32_32x32x16_bf16(a1, qr[d0], p1, 0, 0, 0); }
}
__device__ __forceinline__ void softmax_pv(f32x16& p0, f32x16& p1, const LAS unsigned char* Vs, f32x16 (&o)[2], float& m, float& l, int lane) {
    float mx = p0[0];
#pragma unroll
    for (int r = 0; r < 16; ++r) { mx = fmaxf(mx, p0[r]); mx = fmaxf(mx, p1[r]); }
    mx = fmaxf(mx, __shfl_xor(mx, 32));
    const float mn = fmaxf(m, mx); const float alpha = __builtin_amdgcn_exp2f(m - mn); m = mn;
    float rs = 0.f;
#pragma unroll
    for (int r = 0; r < 16; ++r) { p0[r] = __builtin_amdgcn_exp2f(p0[r] - mn); p1[r] = __builtin_amdgcn_exp2f(p1[r] - mn); rs += p0[r] + p1[r]; }
    rs += __shfl_xor(rs, 32);
    l = l * alpha + rs;
#pragma unroll
    for (int r = 0; r < 16; ++r) { o[0][r] *= alpha; o[1][r] *= alpha; }
    v4u pf[4];
    pf[0] = (v4u){cvtpk(p0[0], p0[1]), cvtpk(p0[2], p0[3]), cvtpk(p0[4], p0[5]), cvtpk(p0[6], p0[7])};
    pf[1] = (v4u){cvtpk(p0[8], p0[9]), cvtpk(p0[10], p0[11]), cvtpk(p0[12], p0[13]), cvtpk(p0[14], p0[15])};
    pf[2] = (v4u){cvtpk(p1[0], p1[1]), cvtpk(p1[2], p1[3]), cvtpk(p1[4], p1[5]), cvtpk(p1[6], p1[7])};
    pf[3] = (v4u){cvtpk(p1[8], p1[9]), cvtpk(p1[10], p1[11]), cvtpk(p1[12], p1[13]), cvtpk(p1[14], p1[15])};
    const int i16 = lane & 15, g4 = lane >> 4;
    const LAS unsigned char* vb = Vs + (4 * (g4 >> 1) + (i16 >> 2)) * KSTR + (16 * (g4 & 1) + 4 * (i16 & 3)) * 2;
#pragma unroll
    for (int dh = 0; dh < 2; ++dh)
#pragma unroll
        for (int s = 0; s < 4; ++s) { const s16x4 lo = vtr(vb + (16 * s) * KSTR + dh * 64), hi4 = vtr(vb + (16 * s + 8) * KSTR + dh * 64);
            const bf16x8 vf = (bf16x8){lo[0], lo[1], lo[2], lo[3], hi4[0], hi4[1], hi4[2], hi4[3]};
            o[dh] = __builtin_amdgcn_mfma_f32_32x32x16_bf16(vf, __builtin_bit_cast(bf16x8, pf[s]), o[dh], 0, 0, 0); }
}
__device__ __forceinline__ float lut_bias(const LAS float* lut_h, int dist) { return lut_h[med3i(dist, -1, 128) + 1]; }

__device__ __forceinline__ void store_o(bf16* orow, const f32x16 (&o)[2], int hi) {
#pragma unroll
    for (int dh = 0; dh < 2; ++dh)
#pragma unroll
        for (int a = 0; a < 4; ++a) { u32x2 w; w.x = pk2(o[dh][4 * a], o[dh][4 * a + 1]); w.y = pk2(o[dh][4 * a + 2], o[dh][4 * a + 3]);
            *(GAS u32x2*)(orow + 32 * dh + 8 * a + 4 * hi) = w; }
}
__device__ __forceinline__ void build_lut(LAS float* lut, const float* rel_bias, int g, int tid) {
    for (int i = tid; i < 4 * 130; i += 512) { const int h = i / 130, idx = i % 130;
        lut[i] = (idx == 0) ? -INFINITY : rel_bias[(int)BUCKET[idx - 1 > 128 ? 128 : idx - 1] * NH + g * 4 + h] * LOG2E; }
}

struct NsaArgs { const bf16* Q; const bf16* KV; const bf16* kcmp; const bf16* vcmp; const float* gates; const float* rel_bias; bf16* O; unsigned* work; };
__device__ __forceinline__ void nsa_unit(const NsaArgs& A, LAS unsigned char* lds, int b, int g, int qb, int tid) {
    const int lane = tid & 63, wid = __builtin_amdgcn_readfirstlane(tid >> 6), r32 = lane & 31, hi = lane >> 5;
    const int ql = 8 * wid + (r32 >> 2), hj = r32 & 3, s0 = 64 * qb, tq = s0 + ql, bg = b * 4 + g;
    LAS float* lut = (LAS float*)(lds + L_LUT); const LAS float* lut_h = lut + hj * 130;
    LAS float* P4 = (LAS float*)(lds + L_P4); LAS float* P3 = (LAS float*)(lds + L_P3);
    LAS unsigned long long* selm = (LAS unsigned long long*)(lds + L_SEL); LAS unsigned long long* uni = (LAS unsigned long long*)(lds + L_UNI);
    build_lut(lut, A.rel_bias, g, tid);
    for (int i = tid; i < 8192; i += 512) P4[i] = 0.f;
    const size_t trow = (size_t)b * SEQ + tq;
    bf16x8 qr[4];
    { const bf16* qp = A.Q + trow * DM + g * 256 + hj * 64 + hi * 8;
#pragma unroll
      for (int d0 = 0; d0 < 4; ++d0) qr[d0] = *(const GAS bf16x8*)(qp + d0 * 16); }
    const float* gp = A.gates + trow * 48 + g * 4 + hj; const float gt0 = gp[0], gt1 = gp[16], gt2 = gp[32];
    f32x16 oacc[2]; oacc[0] = (f32x16){}; oacc[1] = (f32x16){};
    f32x16 o[2], p0, p1; float m, l; TileRegs tr;
    int buf = 0;
    const int ncmp = 4 * qb + 3, ntc = (ncmp + 63) >> 6;
    const bf16* kc = A.kcmp + (size_t)bg * 256 * 64; const bf16* vc = A.vcmp + (size_t)bg * 256 * 64;
    o[0] = (f32x16){}; o[1] = (f32x16){}; m = NEG_BIG; l = 0.f;
    tile_load(tr, kc, vc, tid, true);
    for (int ct = 0; ct < ntc; ++ct) {
        tile_store(tr, lds, buf, tid, true); __syncthreads();
        if (ct + 1 < ntc) tile_load(tr, kc + (ct + 1) * 4096, vc + (ct + 1) * 4096, tid, true);
        qk_tile(p0, p1, lds + L_K0 + buf * TILE_B, qr, r32, hi);
        const int dbase = tq - 31 - 16 * (64 * ct);
#pragma unroll
        for (int r = 0; r < 16; ++r) { const int d0_ = dbase - 16 * crow(r, hi), d1_ = d0_ - 16 * 32;
            p0[r] = d0_ >= 0 ? p0[r] + lut_bias(lut_h, d0_) : -INFINITY; p1[r] = d1_ >= 0 ? p1[r] + lut_bias(lut_h, d1_) : -INFINITY; }
        softmax_pv(p0, p1, lds + L_V0 + buf * TILE_B, o, m, l, lane);
        buf ^= 1;
    }
    const float linv_c = l > 0.f ? 1.0f / l : 0.f; const float m_c = m;
    { const float sc = gt0 * linv_c;
#pragma unroll
      for (int r = 0; r < 16; ++r) { oacc[0][r] += sc * o[0][r]; oacc[1][r] += sc * o[1][r]; } }
    tile_load(tr, kc, vc, tid, false);
    for (int ct = 0; ct < ntc; ++ct) {
        tile_store(tr, lds, buf, tid, false); __syncthreads();
        if (ct + 1 < ntc) tile_load(tr, kc + (ct + 1) * 4096, vc, tid, false);
        qk_tile(p0, p1, lds + L_K0 + buf * TILE_B, qr, r32, hi);
        const int dbase = tq - 31 - 16 * (64 * ct);
#pragma unroll
        for (int r = 0; r < 16; ++r) { const int d0_ = dbase - 16 * crow(r, hi), d1_ = d0_ - 16 * 32;
            p0[r] = d0_ >= 0 ? __builtin_amdgcn_exp2f(p0[r] + lut_bias(lut_h, d0_) - m_c) * linv_c : 0.f;
            p1[r] = d1_ >= 0 ? __builtin_amdgcn_exp2f(p1[r] + lut_bias(lut_h, d1_) - m_c) * linv_c : 0.f; }
#pragma unroll
        for (int pp = 0; pp < 2; ++pp)
#pragma unroll
            for (int a = 0; a < 4; ++a) { float s3 = pp ? p1[4 * a + 3] : p0[4 * a + 3];
                float s4 = pp ? (p1[4 * a] + p1[4 * a + 1]) + (p1[4 * a + 2] + p1[4 * a + 3]) : (p0[4 * a] + p0[4 * a + 1]) + (p0[4 * a + 2] + p0[4 * a + 3]);
                s4 += __shfl_xor(s4, 1); s4 += __shfl_xor(s4, 2); s3 += __shfl_xor(s3, 1); s3 += __shfl_xor(s3, 2);
                if (hj == 0) { const int j = 16 * ct + 8 * pp + 2 * a + hi; P4[ql * 64 + j] = s4; P3[ql * 64 + j] = s3; } }
        buf ^= 1;
    }
    __syncthreads();
    { unsigned long long un = 0ull;
      for (int i = 0; i < 8; ++i) { const int q = 8 * wid + i; const int j = lane;
          float v = P4[q * 64 + j] + (j > 0 ? P3[q * 64 + j - 1] : 0.f);
          const bool forced = (j == 0) || (j == qb) || (j == qb - 1), future = j > qb;
          v = forced ? 1e9f : (future ? -1e9f : v);
          int cnt = 0;
#pragma unroll
          for (int k = 0; k < 64; ++k) { const float vk = __int_as_float(__builtin_amdgcn_readlane(__float_as_int(v), k)); cnt += ((vk > v) || (vk == v && k < j)) ? 1 : 0; }
          const unsigned long long mk = __ballot(cnt < 16);
          if (lane == 0) selm[q] = mk;
          un |= mk; }
      if (lane == 0) uni[wid] = un; }
    __syncthreads();
    unsigned long long umask = 0ull;
#pragma unroll
    for (int w = 0; w < 8; ++w) umask |= uni[w];
    const unsigned long long mymask = selm[ql];
    const bf16* ks = A.KV + (2 * KVT) + (size_t)bg * SEQ * 64; const bf16* vs = A.KV + (3 * KVT) + (size_t)bg * SEQ * 64;
    o[0] = (f32x16){}; o[1] = (f32x16){}; m = NEG_BIG; l = 0.f;
    { int j = 0; while (j <= qb && !((umask >> j) & 1ull)) ++j;
      tile_load(tr, ks + (size_t)j * 4096, vs + (size_t)j * 4096, tid, true);
      while (j <= qb) {
          int jn = j + 1; while (jn <= qb && !((umask >> jn) & 1ull)) ++jn;
          tile_store(tr, lds, buf, tid, true); __syncthreads();
          if (jn <= qb) tile_load(tr, ks + (size_t)jn * 4096, vs + (size_t)jn * 4096, tid, true);
          const bool rowsel = (mymask >> j) & 1ull;
          if (__any(rowsel)) {
              qk_tile(p0, p1, lds + L_K0 + buf * TILE_B, qr, r32, hi);
              const int dbase = tq - 64 * j;
#pragma unroll
              for (int r = 0; r < 16; ++r) { const int d0_ = dbase - crow(r, hi), d1_ = d0_ - 32;
                  p0[r] = (rowsel && d0_ >= 0) ? p0[r] + lut_bias(lut_h, d0_) : -INFINITY; p1[r] = (rowsel && d1_ >= 0) ? p1[r] + lut_bias(lut_h, d1_) : -INFINITY; }
              softmax_pv(p0, p1, lds + L_V0 + buf * TILE_B, o, m, l, lane);
          }
          buf ^= 1; j = jn;
      } }
    { const float sc = gt1 * (l > 0.f ? 1.0f / l : 0.f);
#pragma unroll
      for (int r = 0; r < 16; ++r) { oacc[0][r] += sc * o[0][r]; oacc[1][r] += sc * o[1][r]; } }
    const bf16* kw = A.KV + (4 * KVT) + (size_t)bg * SEQ * 64; const bf16* vw = A.KV + (5 * KVT) + (size_t)bg * SEQ * 64;
    o[0] = (f32x16){}; o[1] = (f32x16){}; m = NEG_BIG; l = 0.f;
    { const int j0 = qb >= 8 ? qb - 8 : 0;
      tile_load(tr, kw + (size_t)j0 * 4096, vw + (size_t)j0 * 4096, tid, true);
      for (int j = j0; j <= qb; ++j) {
          tile_store(tr, lds, buf, tid, true); __syncthreads();
          if (j + 1 <= qb) tile_load(tr, kw + (size_t)(j + 1) * 4096, vw + (size_t)(j + 1) * 4096, tid, true);
          qk_tile(p0, p1, lds + L_K0 + buf * TILE_B, qr, r32, hi);
          const int dbase = tq - 64 * j;
#pragma unroll
          for (int r = 0; r < 16; ++r) { const int d0_ = dbase - crow(r, hi), d1_ = d0_ - 32;
              p0[r] = (d0_ >= 0 && d0_ < 512) ? p0[r] + lut_bias(lut_h, d0_) : -INFINITY; p1[r] = (d1_ >= 0 && d1_ < 512) ? p1[r] + lut_bias(lut_h, d1_) : -INFINITY; }
          softmax_pv(p0, p1, lds + L_V0 + buf * TILE_B, o, m, l, lane);
          buf ^= 1;
      } }
    { const float sc = gt2 * (l > 0.f ? 1.0f / l : 0.f);
#pragma unroll
      for (int r = 0; r < 16; ++r) { oacc[0][r] += sc * o[0][r]; oacc[1][r] += sc * o[1][r]; } }
    store_o(A.O + trow * DM + g * 256 + hj * 64, oacc, hi);
    __syncthreads();
}
__device__ __forceinline__ void nsa_phase(const NsaArgs& A, LAS unsigned char* lds, int tid) {
    LAS int* nextu = (LAS int*)(lds + L_NEXT);
    for (;;) {
        if (tid == 0) nextu[0] = (int)__hip_atomic_fetch_add(A.work, 1u, __ATOMIC_RELAXED, __HIP_MEMORY_SCOPE_AGENT);
        __syncthreads();
        const int u = nextu[0];
        __syncthreads();
        if (u >= NB * NG * 64) break;
        const int qb = 63 - (u >> 5), bg = u & 31;
        nsa_unit(A, lds, bg >> 2, bg & 3, qb, tid);
    }
}

struct SwaArgs { const bf16* Q; const bf16* KV; const float* sinks; const float* rel_bias; bf16* O; };
__device__ __forceinline__ void swa_unit(const SwaArgs& A, LAS unsigned char* lds, int b, int g, int qb, int tid) {
    const int lane = tid & 63, wid = __builtin_amdgcn_readfirstlane(tid >> 6), r32 = lane & 31, hi = lane >> 5;
    const int ql = 8 * wid + (r32 >> 2), hj = r32 & 3, s0 = 64 * qb, tq = s0 + ql, bg = b * 4 + g;
    LAS float* lut = (LAS float*)(lds + L_LUT); const LAS float* lut_h = lut + hj * 130;
    build_lut(lut, A.rel_bias, g, tid);
    const size_t trow = (size_t)b * SEQ + tq;
    bf16x8 qr[4];
    { const bf16* qp = A.Q + trow * DM + g * 256 + hj * 64 + hi * 8;
#pragma unroll
      for (int d0 = 0; d0 < 4; ++d0) qr[d0] = *(const GAS bf16x8*)(qp + d0 * 16); }
    f32x16 o[2], p0, p1; TileRegs tr; int buf = 0;
    o[0] = (f32x16){}; o[1] = (f32x16){};
    float m = A.sinks[g * 4 + hj] * LOG2E, l = 1.0f;
    const bf16* kk = A.KV + (size_t)bg * SEQ * 64; const bf16* vv = A.KV + KVT + (size_t)bg * SEQ * 64;
    const int j0 = qb >= 2 ? qb - 2 : 0;
    tile_load(tr, kk + (size_t)j0 * 4096, vv + (size_t)j0 * 4096, tid, true);
    for (int j = j0; j <= qb; ++j) {
        tile_store(tr, lds, buf, tid, true); __syncthreads();
        if (j + 1 <= qb) tile_load(tr, kk + (size_t)(j + 1) * 4096, vv + (size_t)(j + 1) * 4096, tid, true);
        qk_tile(p0, p1, lds + L_K0 + buf * TILE_B, qr, r32, hi);
        const int dbase = tq - 64 * j;
#pragma unroll
        for (int r = 0; r < 16; ++r) { const int d0_ = dbase - crow(r, hi), d1_ = d0_ - 32;
            p0[r] = (d0_ >= 0 && d0_ < 128) ? p0[r] + lut_bias(lut_h, d0_) : -INFINITY; p1[r] = (d1_ >= 0 && d1_ < 128) ? p1[r] + lut_bias(lut_h, d1_) : -INFINITY; }
        softmax_pv(p0, p1, lds + L_V0 + buf * TILE_B, o, m, l, lane);
        buf ^= 1;
    }
    { const float sc = 1.0f / l;
#pragma unroll
      for (int r = 0; r < 16; ++r) { o[0][r] *= sc; o[1][r] *= sc; } }
    store_o(A.O + trow * DM + g * 256 + hj * 64, o, hi);
    __syncthreads();
}
}

using pg8::Unit; using pg8::f32x4;
struct SchedPlain {
    pg8::GridOrder go; int arow_off;
    __device__ bool next(int i, Unit& u) const { u.e = 0; u.lt = 0; return go.tile(i, u.pm, u.pn); }
    __device__ int a_row(const Unit& u, int r) const { return arow_off + u.pm * 256 + r; }
    __device__ int b_row0(const Unit& u) const { return u.pn * 256; }
};
struct SchedCmp {
    pg8::GridOrder go;
    __device__ bool next(int i, Unit& u) const { u.e = 0; u.lt = 0; return go.tile(i, u.pm, u.pn); }
    __device__ int a_row(const Unit& u, int r) const { return u.pm * 256 + r; }
    __device__ int b_row0(const Unit& u) const { return (u.pm >= 32 ? 512 : 0) + u.pn * 256; }
};
struct SchedL1 {
    pg8::GridOrder go; int xb_rowoff;
    __device__ bool next(int i, Unit& u) const { u.e = 0; u.lt = 0; return go.tile(i, u.pm, u.pn); }
    __device__ int a_row(const Unit& u, int r) const { return (u.pn >= 4 ? xb_rowoff : 0) + u.pm * 256 + r; }
    __device__ int b_row0(const Unit& u) const { return u.pn * 256; }
};
template <int NPN, bool GATHER, int BROWS>
struct SchedMoe {
    const unsigned* cnt; const unsigned* list; int G, c;
    __device__ bool next(int i, Unit& u) const {
        const long L = (long)i * G + c; int mt = (int)(L / NPN); u.pn = (int)(L % NPN);
        int base = 0;
        for (int e = 0; e < NE; ++e) { const int n = ((int)cnt[e] + 255) >> 8; if (mt < base + n) { u.e = e; u.lt = mt - base; u.pm = mt; return true; } base += n; }
        return false;
    }
    __device__ int a_row(const Unit& u, int r) const {
        if (!GATHER) return u.pm * 256 + r;
        const int idx = u.lt * 256 + r; return idx < (int)cnt[u.e] ? (int)(list[(size_t)u.e * NT + idx] >> 1) : 0;
    }
    __device__ int b_row0(const Unit& u) const { return u.e * BROWS + u.pn * 256; }
};

__device__ __forceinline__ v4u pack8(const f32x4& a, const f32x4& b, float s) {
    v4u w; w.x = pg8::cvt_pk_bf16(a[0] * s, a[1] * s); w.y = pg8::cvt_pk_bf16(a[2] * s, a[3] * s); w.z = pg8::cvt_pk_bf16(b[0] * s, b[1] * s); w.w = pg8::cvt_pk_bf16(b[2] * s, b[3] * s); return w; }
__device__ __forceinline__ bf16* kv_addr(bf16* KV, int ten, int m, int c) { const int b = m >> 12, s = m & 4095, g = c >> 6, d = c & 63; return KV + (size_t)ten * KVT + ((size_t)((b * 4 + g) * SEQ + s)) * 64 + d; }

struct EpiProj {
    static constexpr bool PERM = true;
    bf16* Q; bf16* KV; float* gates;
    __device__ __forceinline__ void operator()(const f32x4 (&acc)[2][2][4][2], const Unit& u, int wr, int wc, int fr, int fq) const {
#pragma unroll
        for (int ai = 0; ai < 2; ++ai)
#pragma unroll
            for (int m = 0; m < 4; ++m) { const int row = u.pm * 256 + ai * 128 + wr * 64 + m * 16 + fr;
#pragma unroll
                for (int bj = 0; bj < 2; ++bj) { const int ct = bj * 128 + wc * 32 + 8 * fq; const f32x4 v0 = acc[ai][bj][m][0], v1 = acc[ai][bj][m][1];
                    if (u.pn < 4) { *(GAS v4u*)(Q + (size_t)row * DM + u.pn * 256 + ct) = pack8(v0, v1, QSCALE); }
                    else if (u.pn < 10) { *(GAS v4u*)kv_addr(KV, u.pn - 4, row, ct) = pack8(v0, v1, 1.0f); }
                    else if (ct < 48) { float* gp = gates + (size_t)row * 48 + ct;
                        *(GAS f32x4*)gp = (f32x4){sigmoidf_(v0[0]), sigmoidf_(v0[1]), sigmoidf_(v0[2]), sigmoidf_(v0[3])};
                        *(GAS f32x4*)(gp + 4) = (f32x4){sigmoidf_(v1[0]), sigmoidf_(v1[1]), sigmoidf_(v1[2]), sigmoidf_(v1[3])}; } } }
    }
};
struct EpiL1 {
    static constexpr bool PERM = true;
    bf16* Q; bf16* KV;
    __device__ __forceinline__ void operator()(const f32x4 (&acc)[2][2][4][2], const Unit& u, int wr, int wc, int fr, int fq) const {
#pragma unroll
        for (int ai = 0; ai < 2; ++ai)
#pragma unroll
            for (int m = 0; m < 4; ++m) { const int row = u.pm * 256 + ai * 128 + wr * 64 + m * 16 + fr;
#pragma unroll
                for (int bj = 0; bj < 2; ++bj) { const int ct = bj * 128 + wc * 32 + 8 * fq; const f32x4 v0 = acc[ai][bj][m][0], v1 = acc[ai][bj][m][1];
                    if (u.pn < 4) { *(GAS v4u*)(Q + (size_t)row * DM + u.pn * 256 + ct) = pack8(v0, v1, QSCALE); }
                    else { *(GAS v4u*)kv_addr(KV, u.pn - 4, row, ct) = pack8(v0, v1, 1.0f); } } }
    }
};
struct EpiF32 {
    static constexpr bool PERM = false;
    float* O; int ldc;
    __device__ __forceinline__ void operator()(const f32x4 (&acc)[2][2][4][2], const Unit& u, int wr, int wc, int fr, int fq) const {
#pragma unroll
        for (int ai = 0; ai < 2; ++ai)
#pragma unroll
            for (int m = 0; m < 4; ++m) { float* rp = O + (size_t)(u.pm * 256 + ai * 128 + wr * 64 + m * 16 + fr) * ldc + u.pn * 256 + wc * 32 + 4 * fq;
#pragma unroll
                for (int bj = 0; bj < 2; ++bj)
#pragma unroll
                    for (int n = 0; n < 2; ++n) *(GAS f32x4*)(rp + bj * 128 + n * 16) = acc[ai][bj][m][n]; }
    }
};
struct EpiBf16 {
    static constexpr bool PERM = true;
    bf16* O; int ldc;
    __device__ __forceinline__ void operator()(const f32x4 (&acc)[2][2][4][2], const Unit& u, int wr, int wc, int fr, int fq) const {
#pragma unroll
        for (int ai = 0; ai < 2; ++ai)
#pragma unroll
            for (int m = 0; m < 4; ++m) { bf16* rp = O + (size_t)(u.pm * 256 + ai * 128 + wr * 64 + m * 16 + fr) * ldc + u.pn * 256 + wc * 32 + 8 * fq;
#pragma unroll
                for (int bj = 0; bj < 2; ++bj) *(GAS v4u*)(rp + bj * 128) = pack8(acc[ai][bj][m][0], acc[ai][bj][m][1], 1.0f); }
    }
};
struct EpiGU {
    static constexpr bool PERM = true;
    bf16* he;
    __device__ __forceinline__ void operator()(const f32x4 (&acc)[2][2][4][2], const Unit& u, int wr, int wc, int fr, int fq) const {
#pragma unroll
        for (int ai = 0; ai < 2; ++ai)
#pragma unroll
            for (int m = 0; m < 4; ++m) { bf16* rp = he + (size_t)(u.pm * 256 + ai * 128 + wr * 64 + m * 16 + fr) * DE + u.pn * 128 + wc * 32 + 8 * fq;
                f32x4 h0, h1;
#pragma unroll
                for (int k = 0; k < 4; ++k) { h0[k] = siluf_(acc[ai][0][m][0][k]) * acc[ai][1][m][0][k]; h1[k] = siluf_(acc[ai][0][m][1][k]) * acc[ai][1][m][1][k]; }
                *(GAS v4u*)rp = pack8(h0, h1, 1.0f); }
    }
};
struct Args { const float* in[24]; float* out; unsigned char* ws; int ph_lo, ph_hi; };
__global__ void __launch_bounds__(NWAVES * 64, 2) fwd(Args args) {
    extern __shared__ __attribute__((aligned(16))) unsigned char lds_raw[];
    LAS unsigned char* lds = (LAS unsigned char*)lds_raw;
    const int tid = threadIdx.x, lane = tid & 63, wave = __builtin_amdgcn_readfirstlane(tid >> 6);
    const int G = gridDim.x, blk = blockIdx.x;
    const int gw = blk * NWAVES + wave, ngw = G * NWAVES;
    unsigned char* ws = args.ws;
    gu32* ctl = (gu32*)(ws + WS_CTL);
    volatile LAS unsigned* MISC = (volatile LAS unsigned*)(lds + MISC_OFF);
    if (tid < 64) MISC[tid] = 0u;
    __syncthreads();
    XcdBarrier bar; bar.bar = (unsigned*)ctl + CW_BAR; bar.x = 0; bar.st = nullptr;
    if (MK_N_LAUNCHES == 1) bar = xcd_barrier_post((unsigned*)ctl + CW_BAR, MISC + 8);
    const int lo = args.ph_lo, hi = args.ph_hi;
#ifndef PHASE_MASK
#define PHASE_MASK 0x3ffff
#endif
#define IN(k) (((PHASE_MASK >> (k)) & 1) && lo <= (k) && (k) < hi)
#define SEAM(k) do { if (IN(k) && IN((k) + 1)) xcd_barrier(bar); } while (0)
#define x (args.in[0])
#define c_in (args.in[1])
#define nsa_w_in (args.in[2])
#define cmp_k_w1 (args.in[3])
#define cmp_k_w2 (args.in[4])
#define cmp_v_w1 (args.in[5])
#define cmp_v_w2 (args.in[6])
#define cmp_k_pos (args.in[7])
#define cmp_v_pos (args.in[8])
#define nsa_w_out (args.in[9])
#define swa_w_q (args.in[10])
#define swa_sinks (args.in[11])
#define swa_w_out (args.in[12])
#define shared_w_kv (args.in[13])
#define rel_bias (args.in[14])
#define router_w (args.in[15])
#define router_b (args.in[16])
#define moe_w_gate (args.in[17])
#define moe_w_up (args.in[18])
#define moe_w_down (args.in[19])
#define ada_w (args.in[20])
#define ada_b (args.in[21])
#define ln_g (args.in[22])
#define ln_b (args.in[23])
#define out (args.out)
#define bufA ((bf16*)(ws + WS_A))
#define bufB ((bf16*)(ws + WS_B))
#define bufC ((bf16*)(ws + WS_C))
#define bufD ((bf16*)(ws + WS_D))
#define cnt0 ((unsigned*)ctl + CW_CNT0)
#define cnt1 ((unsigned*)ctl + CW_CNT1)
#define list ((const unsigned*)(ws + WS_LIST))
#define tokw ((const float*)(ws + WS_TOKW))

    if (IN(0)) {
        P0Args a{c_in, nsa_w_in, cmp_k_w1, cmp_v_w1, cmp_k_pos, cmp_v_pos, nsa_w_out, swa_w_q, shared_w_kv, swa_w_out, moe_w_gate, moe_w_up, moe_w_down, ada_w, ada_b, ws};
        p0_small(a, lds, blk, G, tid);
        p0_transposes(a, lds, gw, ngw, wave, lane);
    }
    SEAM(0);
    if (IN(1)) p_modulate(x, ws, 0, bufA, gw, ngw, lane);
    SEAM(1);
    if (IN(2)) {
        pg8::Gemm g{bufA, (const bf16*)(ws + WS_WIN), DM, DM}; SchedPlain S; S.go.init(NT / 256, NPROJ / 256, G, blk); S.arow_off = 0;
        EpiProj E{bufB, bufC, (float*)(ws + WS_GATE)};
        pg8::gemm_phase(lds + RING_OFF, g, S, E);
    }
    SEAM(2);
    if (IN(3)) {
        pg8::Gemm g{bufC, (const bf16*)(ws + WS_CW1), DM, DM}; SchedCmp S; S.go.init(64, 2, G, blk);
        EpiF32 E{(float*)(ws + WS_UL), 512};
        pg8::gemm_phase(lds + RING_OFF, g, S, E);
    }
    SEAM(3);
    if (IN(4)) p_cmp_tail(cmp_k_w2, cmp_v_w2, ws, lds, blk, G, tid);
    SEAM(4);
    if (IN(5)) {
        att::NsaArgs A{bufB, bufC, (const bf16*)(ws + WS_KCMP), (const bf16*)(ws + WS_VCMP), (const float*)(ws + WS_GATE), rel_bias, bufA, (unsigned*)ctl + 64};
        att::nsa_phase(A, lds, tid);
    }
    SEAM(5);
    if (IN(6)) {
        pg8::Gemm g{bufA, (const bf16*)(ws + WS_WOUT0), DM, DM}; SchedPlain S; S.go.init(NT / 256, 4, G, blk); S.arow_off = 0;
        EpiBf16 E{bufB, DM};
        pg8::gemm_phase(lds + RING_OFF, g, S, E);
    }
    SEAM(6);
    if (IN(7)) { LnRouterArgs a{x, out, bufB, bufA, ln_g, ln_b, router_w, router_b, ws, 0, cnt0}; p_ln_router(a, lds, blk, G, tid); }
    SEAM(7);
    if (IN(8)) {
        pg8::Gemm g{bufA, (const bf16*)(ws + WS_WGU), DM, DM}; SchedMoe<2, true, 512> S{cnt0, list, G, blk};
        EpiGU E{bufD};
        pg8::gemm_phase(lds + RING_OFF, g, S, E);
    }
    SEAM(8);
    if (IN(9)) {
        pg8::Gemm g{bufD, (const bf16*)(ws + WS_WD), DE, DE}; SchedMoe<4, false, 1024> S{cnt0, list, G, blk};
        EpiBf16 E{bufC, DM};
        pg8::gemm_phase(lds + RING_OFF, g, S, E);
    }
    SEAM(9);
    if (IN(10)) p_ln_ffn(out, bufC, ln_g + DM, ln_b + DM, ws, 0, true, bufD, bufA, cnt0, lds, gw, ngw, tid);
    SEAM(10);
    if (IN(11)) {
        pg8::Gemm g{bufA, (const bf16*)(ws + WS_WQ1), DM, DM}; SchedL1 S; S.go.init(NT / 256, 6, G, blk); S.xb_rowoff = (int)((WS_D - WS_A) / (DM * 2));
        EpiL1 E{bufB, bufC};
        pg8::gemm_phase(lds + RING_OFF, g, S, E);
    }
    SEAM(11);
    if (IN(12)) {
        att::SwaArgs A{bufB, bufC, swa_sinks, rel_bias, bufA};
        for (int u = blk; u < NB * NG * 64; u += G) att::swa_unit(A, lds, u >> 8, (u >> 6) & 3, u & 63, tid);
    }
    SEAM(12);
    if (IN(13)) {
        pg8::Gemm g{bufA, (const bf16*)(ws + WS_WOUT1), DM, DM}; SchedPlain S; S.go.init(NT / 256, 4, G, blk); S.arow_off = 0;
        EpiBf16 E{bufB, DM};
        pg8::gemm_phase(lds + RING_OFF, g, S, E);
    }
    SEAM(13);
    if (IN(14)) { LnRouterArgs a{out, out, bufB, bufA, ln_g + 2 * DM, ln_b + 2 * DM, router_w, router_b, ws, 1, cnt1}; p_ln_router(a, lds, blk, G, tid); }
    SEAM(14);
    if (IN(15)) {
        pg8::Gemm g{bufA, (const bf16*)(ws + WS_WGU) + (size_t)NE * 512 * DM, DM, DM}; SchedMoe<2, true, 512> S{cnt1, list, G, blk};
        EpiGU E{bufD};
        pg8::gemm_phase(lds + RING_OFF, g, S, E);
    }
    SEAM(15);
    if (IN(16)) {
        pg8::Gemm g{bufD, (const bf16*)(ws + WS_WD) + (size_t)NE * DM * DE, DE, DE}; SchedMoe<4, false, 1024> S{cnt1, list, G, blk};
        EpiBf16 E{bufC, DM};
        pg8::gemm_phase(lds + RING_OFF, g, S, E);
    }
    SEAM(16);
    if (IN(17)) p_ln_ffn(out, bufC, ln_g + 3 * DM, ln_b + 3 * DM, ws, 1, false, nullptr, nullptr, cnt1, lds, gw, ngw, tid);
#undef IN
#undef SEAM
#undef x
#undef c_in
#undef out
#undef list
#undef tokw
#undef bufA
#undef bufB
#undef bufC
#undef bufD
#undef cnt0
#undef cnt1
#undef ln_g
#undef ln_b
#undef rel_bias
#undef router_w
#undef router_b
}

extern "C" void kernel_launch(void* const* d_in, const int* in_sizes, int n_in, void* d_out, int out_size, void* d_ws, size_t ws_size, hipStream_t stream) {
    static int grid = 0;
    if (grid == 0) {
        if (n_in != 24 || in_sizes[0] != NT * DM || out_size != NT * DM || ws_size < WS_END) { fprintf(stderr, "kernel_launch: unexpected shapes (n_in %d, in0 %d, out %d, ws %zu); nothing launched\n", n_in, n_in > 0 ? in_sizes[0] : -1, out_size, ws_size); grid = -1; return; }
        int dev = 0, cus = 0, per_cu = 0;
        if (hipGetDevice(&dev) != hipSuccess || hipDeviceGetAttribute(&cus, hipDeviceAttributeMultiprocessorCount, dev) != hipSuccess) { grid = -1; return; }
        if (hipFuncSetAttribute((const void*)fwd, hipFuncAttributeMaxDynamicSharedMemorySize, LDS_BYTES) != hipSuccess) { fprintf(stderr, "kernel_launch: hipFuncSetAttribute failed\n"); grid = -1; return; }
        if (hipOccupancyMaxActiveBlocksPerMultiprocessor(&per_cu, (const void*)fwd, NWAVES * 64, LDS_BYTES) != hipSuccess || per_cu < 1) fprintf(stderr, "kernel_launch: occupancy query reports %d\n", per_cu);
        (void)hipGetLastError();
        grid = cus;
        if (grid != 256) { fprintf(stderr, "kernel_launch: built for a 256-CU device, found %d CUs; nothing launched\n", cus); grid = -1; return; }
    }
    if (grid < 0) return;
    if (hipMemsetAsync((char*)d_ws + WS_CTL, 0, CTL_ZERO_BYTES, stream) != hipSuccess) return;
    Args a{};
    for (int i = 0; i < 24; ++i) a.in[i] = (const float*)d_in[i];
    a.out = (float*)d_out; a.ws = (unsigned char*)d_ws;
#if MK_N_LAUNCHES == 1
    a.ph_lo = 0; a.ph_hi = N_PHASES;
    hipLaunchKernelGGL(fwd, dim3(grid), dim3(NWAVES * 64), LDS_BYTES, stream, a);
#else
    for (int p = 0; p < N_PHASES; ++p) { a.ph_lo = p; a.ph_hi = p + 1; hipLaunchKernelGGL(fwd, dim3(grid), dim3(NWAVES * 64), LDS_BYTES, stream, a); }
#endif
}
```

```cpp
#include <hip/hip_runtime.h>
#include <cstdio>
#include <cstdint>

#ifndef MK_N_LAUNCHES
#define MK_N_LAUNCHES 1
#endif
constexpr int N_PHASES = 18;
#ifndef DBG_SCALES
#define DBG_SCALES 1.0f, 1.0f, 1.0f, 1.0f
#endif
constexpr float DBG_ARR[4] = {DBG_SCALES};
constexpr float DBG_S0 = DBG_ARR[0], DBG_S1 = DBG_ARR[1], DBG_S2 = DBG_ARR[2], DBG_SWA = DBG_ARR[3];

constexpr int NB = 8, SEQ = 4096, DM = 1024, NT = NB * SEQ;
constexpr int NH = 16, NG = 4, NJ = 4, HD = 64;
constexpr int NSA_IN = 2608, NPROJ = 2816;
constexpr int NE = 16, DE = 256;
constexpr float ALPHA_F = 1.4142135623730951f;
constexpr float LN_EPS_F = 1e-5f;
constexpr float LOG2E = 1.4426950408889634f;
constexpr float QSCALE = 0.125f * LOG2E;
constexpr float NEG_BIG = -1e30f;

constexpr size_t MiB = 1u << 20;
constexpr size_t WS_CTL = 0, CTL_ZERO_BYTES = 1 * MiB;
constexpr size_t WS_ADA = 1 * MiB;
constexpr size_t WS_POSB = WS_ADA + 2 * 8 * 6144 * 4;
constexpr size_t WS_TBL = WS_ADA + 512 * 1024;
constexpr size_t WS_WIN = 2 * MiB;
constexpr size_t WS_CW1 = 8 * MiB;
constexpr size_t WS_WOUT0 = 10 * MiB, WS_WQ1 = 12 * MiB, WS_WKV = 14 * MiB, WS_WOUT1 = 15 * MiB;
constexpr size_t WS_WGU = 18 * MiB;
constexpr size_t WS_WD = 50 * MiB;
constexpr size_t WS_LIST = 66 * MiB;
constexpr size_t WS_TOKW = 68 * MiB;
constexpr size_t WS_TOKPOS = WS_TOKW + 512 * 1024;
constexpr size_t WS_KCMP = 69 * MiB, WS_VCMP = 70 * MiB;
constexpr size_t WS_GATE = 71 * MiB;
constexpr size_t WS_A = 80 * MiB;
constexpr size_t WS_B = 144 * MiB;
constexpr size_t WS_C = 208 * MiB;
constexpr size_t WS_UL = WS_C + 100 * MiB;
constexpr size_t WS_D = 344 * MiB;
constexpr size_t WS_E = 408 * MiB;
constexpr size_t WS_END = 472 * MiB;
constexpr size_t KVT = (size_t)NB * NG * SEQ * HD;
constexpr int CW_BAR = 4096;
constexpr int CW_CNT0 = 16384, CW_CNT1 = 16384 + 64;
constexpr int CW_DEP0 = 16384 + 128, CW_DEP1 = 16384 + 192;

namespace pg8 {
#define PG8_LAS __attribute__((address_space(3)))
typedef unsigned short bf16_t;
typedef short bf16x8 __attribute__((ext_vector_type(8)));
typedef float f32x4 __attribute__((ext_vector_type(4)));
typedef unsigned u32x4 __attribute__((ext_vector_type(4)));
constexpr int BM = 256, BK = 64, HALF = 128, HTB = HALF * BK * 2  , STAGE_BYTES = 8 * HTB, NXCD = 8, WGM = 8;

__host__ __device__ __forceinline__ int lds_byte(int r, int c) { const int st = (r >> 4) * 2 + (c >> 5), rr = r & 15, cc = c & 31, ob = rr * 64 + cc * 2; return st * 1024 + (ob ^ (((ob >> 9) & 1) << 5)); }
__host__ __device__ __forceinline__ void stage_rc(int b, int& R, int& C) { const int st = b / 1024, sb = b % 1024, swz = sb ^ (((sb >> 9) & 1) << 5); R = (st >> 1) * 16 + swz / 64; C = (st & 1) * 32 + (swz % 64) / 2; }
__host__ __device__ __forceinline__ int perm32(int rho) { const int n = rho >> 4, i = rho & 15; return 8 * (i >> 2) + 4 * n + (i & 3); }

struct Unit { int pm, pn, e, lt; };
struct Gemm { const bf16_t* A; const bf16_t* Bt; int lda; int K; };

struct GridOrder {
    int nM, nN, nwg, G, c;
    __device__ void init(int nM_, int nN_, int G_, int c_) { nM = nM_; nN = nN_; nwg = nM * nN; G = G_; c = c_; }
    __device__ bool tile(int i, int& pm, int& pn) const {
        const long L = (long)i * G + c; if (L >= nwg) return false;
        int wgid = (int)L; { const int q = nwg / NXCD, r = nwg % NXCD, xcd = wgid % NXCD, off = wgid / NXCD; wgid = (xcd < r ? xcd * (q + 1) : r * (q + 1) + (xcd - r) * q) + off; }
        const int nig = WGM * nN, gid = wgid / nig, fm = gid * WGM, gsz = (nM - fm) < WGM ? (nM - fm) : WGM;
        pm = fm + ((wgid % nig) % gsz); pn = (wgid % nig) / gsz; return true;
    }
};

__device__ __forceinline__ unsigned cvt_pk_bf16(float lo, float hi) { unsigned r; asm volatile("v_cvt_pk_bf16_f32 %0, %1, %2" : "=v"(r) : "v"(lo), "v"(hi)); return r; }

template <class Epi, class Sched>
__device__ __forceinline__ void gemm_phase(PG8_LAS unsigned char* lds, const Gemm g, const Sched& S, const Epi& E) {
    const int tid = threadIdx.x, wid = __builtin_amdgcn_readfirstlane(tid >> 6), lane = tid & 63, wr = wid >> 2, wc = wid & 3, fr = lane & 15, fq = lane >> 4;
    int K = g.K; asm volatile("" : "+s"(K));
    const int nt = K / BK;
    int RA[2], CA[2]; unsigned voffB[2];
#pragma unroll
    for (int i = 0; i < 2; ++i) { int R, C; stage_rc(tid * 16 + i * 8192, R, C); const int Rb = Epi::PERM ? ((R & ~31) + perm32(R & 31)) : R;
        RA[i] = R; CA[i] = C; voffB[i] = (unsigned)(Rb * K + C) * 2u; }
    const size_t kstep = (size_t)(BK * 2);
    const size_t hstep = (size_t)HALF * K * 2;
    const unsigned ldsw = (unsigned)wid * 1024u;
    const int aoff = lds_byte(wr * 64 + fr, fq * 8), boff = lds_byte(wc * 32 + fr, fq * 8);
#define PG8_SA(b, h) (((b) * 2 + (h)) * HTB)
#define PG8_SB(b, h) ((4 + (b) * 2 + (h)) * HTB)
#define PG8_STAGE(bufoff, gbase, voff) do { _Pragma("unroll") for (int _i = 0; _i < 2; ++_i) \
        __builtin_amdgcn_global_load_lds((const unsigned*)((const char*)(gbase) + (voff)[_i]), (PG8_LAS unsigned*)(lds + (bufoff) + ldsw + _i * 8192), 16, 0, 0); } while (0)
#define PG8_AOFFS(ao, u) do { _Pragma("unroll") for (int _h = 0; _h < 2; ++_h) _Pragma("unroll") for (int _i = 0; _i < 2; ++_i) \
        (ao)[_h][_i] = (unsigned)(S.a_row((u), _h * HALF + RA[_i]) * g.lda + CA[_i]) * 2u; } while (0)
#define PG8_LDA(dst, b, h) do { _Pragma("unroll") for (int m = 0; m < 4; ++m) _Pragma("unroll") for (int k = 0; k < 2; ++k) dst[m][k] = *(const PG8_LAS bf16x8*)(lds + PG8_SA(b, h) + aoff + m * 2048 + k * 1024); } while (0)
#define PG8_LDB(dst, b, h) do { _Pragma("unroll") for (int n = 0; n < 2; ++n) _Pragma("unroll") for (int k = 0; k < 2; ++k) dst[n][k] = *(const PG8_LAS bf16x8*)(lds + PG8_SB(b, h) + boff + n * 2048 + k * 1024); } while (0)
#define PG8_MMA(ai, bj, At, Bt) do { __builtin_amdgcn_s_setprio(1); _Pragma("unroll") for (int m = 0; m < 4; ++m) _Pragma("unroll") for (int n = 0; n < 2; ++n) _Pragma("unroll") for (int k = 0; k < 2; ++k) \
        acc[ai][bj][m][n] = __builtin_amdgcn_mfma_f32_16x16x32_bf16(Bt[n][k], At[m][k], acc[ai][bj][m][n], 0, 0, 0); __builtin_amdgcn_s_setprio(0); } while (0)
#define PG8_WAIT_V(n) asm volatile("s_waitcnt vmcnt(" #n ")" ::: "memory")
#define PG8_WAIT_L(n) asm volatile("s_waitcnt lgkmcnt(" #n ")" ::: "memory")
#define PG8_BAR __builtin_amdgcn_s_barrier()
#define PG8_SCHED __builtin_amdgcn_sched_barrier(0)
    Unit cur, nxt; int ui = 0;
    if (!S.next(0, cur)) return;
    f32x4 acc[2][2][4][2];
#pragma unroll
    for (int a = 0; a < 2; ++a)
#pragma unroll
        for (int b = 0; b < 2; ++b)
#pragma unroll
            for (int m = 0; m < 4; ++m)
#pragma unroll
                for (int n = 0; n < 2; ++n) acc[a][b][m][n] = (f32x4){0.f, 0.f, 0.f, 0.f};
    bf16x8 At[4][2], B0[2][2], B1[2][2];
    const char* A0 = (const char*)g.A;
    const char* cB = (const char*)g.Bt + (size_t)S.b_row0(cur) * K * 2;
    unsigned aoc[2][2], aon[2][2];
    PG8_AOFFS(aoc, cur);
    PG8_STAGE(PG8_SB(0, 0), cB, voffB); PG8_STAGE(PG8_SB(0, 1), cB + hstep, voffB); PG8_STAGE(PG8_SA(0, 0), A0, aoc[0]); PG8_STAGE(PG8_SA(0, 1), A0, aoc[1]);
    if (wr == 1) PG8_BAR;
    PG8_WAIT_V(2); PG8_BAR;
    PG8_STAGE(PG8_SB(1, 0), cB + kstep, voffB); PG8_STAGE(PG8_SA(1, 0), A0 + kstep, aoc[0]); PG8_STAGE(PG8_SB(1, 1), cB + hstep + kstep, voffB);
    PG8_WAIT_V(6); PG8_BAR;
    for (;;) {
        const bool has_next = S.next(ui + 1, nxt);
        const char* nB = has_next ? (const char*)g.Bt + (size_t)S.b_row0(nxt) * K * 2 : cB;
        if (has_next) { PG8_AOFFS(aon, nxt); } else {
#pragma unroll
            for (int h = 0; h < 2; ++h)
#pragma unroll
                for (int i = 0; i < 2; ++i) aon[h][i] = aoc[h][i]; }
        for (int t = 0; t < nt; t += 2) {
            const bool last = (t == nt - 2);
            const char* a1 = A0 + (size_t)(t + 1) * kstep;
            const char* a2 = last ? A0 : A0 + (size_t)(t + 2) * kstep; const char* b2 = last ? nB : cB + (size_t)(t + 2) * kstep;
            const char* a3 = a2 + kstep; const char* b3 = b2 + kstep;
            unsigned ao2[2][2];
#pragma unroll
            for (int h = 0; h < 2; ++h)
#pragma unroll
                for (int i = 0; i < 2; ++i) ao2[h][i] = last ? aon[h][i] : aoc[h][i];
            PG8_LDB(B0, 0, 0); PG8_LDB(B1, 0, 1); PG8_SCHED; PG8_LDA(At, 0, 0); PG8_STAGE(PG8_SA(1, 1), a1, aoc[1]);
            PG8_WAIT_V(8); PG8_WAIT_L(0); PG8_BAR; PG8_MMA(0, 0, At, B0); PG8_MMA(0, 1, At, B1); PG8_BAR; PG8_SCHED;
            PG8_LDA(At, 0, 1); PG8_STAGE(PG8_SB(0, 0), b2, voffB); PG8_STAGE(PG8_SB(0, 1), b2 + hstep, voffB); PG8_STAGE(PG8_SA(0, 0), a2, ao2[0]);
            PG8_WAIT_V(8); PG8_WAIT_L(0); PG8_BAR; PG8_MMA(1, 0, At, B0); PG8_MMA(1, 1, At, B1); PG8_BAR; PG8_SCHED;
            PG8_LDB(B0, 1, 0); PG8_LDB(B1, 1, 1); PG8_SCHED; PG8_LDA(At, 1, 0); PG8_STAGE(PG8_SA(0, 1), a2, ao2[1]);
            PG8_WAIT_V(8); PG8_WAIT_L(0); PG8_BAR; PG8_MMA(0, 0, At, B0); PG8_MMA(0, 1, At, B1); PG8_BAR; PG8_SCHED;
            PG8_LDA(At, 1, 1); PG8_STAGE(PG8_SB(1, 0), b3, voffB); PG8_STAGE(PG8_SB(1, 1), b3 + hstep, voffB); PG8_STAGE(PG8_SA(1, 0), a3, ao2[0]);
            PG8_WAIT_V(8); PG8_WAIT_L(0); PG8_BAR; PG8_MMA(1, 0, At, B0); PG8_MMA(1, 1, At, B1); PG8_BAR; PG8_SCHED;
        }
        if (wr == 0) PG8_BAR;
        E(acc, cur, wr, wc, fr, fq);
        if (!has_next) break;
#pragma unroll
        for (int a = 0; a < 2; ++a)
#pragma unroll
            for (int b = 0; b < 2; ++b)
#pragma unroll
                for (int m = 0; m < 4; ++m)
#pragma unroll
                    for (int n = 0; n < 2; ++n) acc[a][b][m][n] = (f32x4){0.f, 0.f, 0.f, 0.f};
        cur = nxt; cB = nB; ++ui;
#pragma unroll
        for (int h = 0; h < 2; ++h)
#pragma unroll
            for (int i = 0; i < 2; ++i) aoc[h][i] = aon[h][i];
        if (wr == 1) PG8_BAR;
    }
    PG8_WAIT_V(0);
    PG8_BAR;
#undef PG8_SA
#undef PG8_SB
#undef PG8_STAGE
#undef PG8_AOFFS
#undef PG8_LDA
#undef PG8_LDB
#undef PG8_MMA
#undef PG8_WAIT_V
#undef PG8_WAIT_L
#undef PG8_BAR
#undef PG8_SCHED
}
}

#define GAS __attribute__((address_space(1)))
#define LAS __attribute__((address_space(3)))
typedef unsigned short bf16;
typedef unsigned v4u __attribute__((ext_vector_type(4)));
typedef float f32x4 __attribute__((ext_vector_type(4)));
typedef short bf16x8 __attribute__((ext_vector_type(8)));
typedef GAS unsigned gu32;
typedef GAS unsigned long long gu64;
#define RLX_AGENT __ATOMIC_RELAXED, __HIP_MEMORY_SCOPE_AGENT
#define LDS_WAIT() asm volatile("s_waitcnt lgkmcnt(0)" ::: "memory")
#define VM_WAIT() asm volatile("s_waitcnt vmcnt(0)" ::: "memory")
__device__ __forceinline__ unsigned long long rt() { return __builtin_amdgcn_s_memrealtime(); }
__device__ __forceinline__ unsigned f2bf(float f) { unsigned u = __builtin_bit_cast(unsigned, f); return (u + 0x7fffu + ((u >> 16) & 1u)) >> 16; }
__device__ __forceinline__ unsigned pk2(float lo, float hi) { return f2bf(lo) | (f2bf(hi) << 16); }

#define XB_TMO      128
#define XB_XCNT(j)  (256  + 64 * (j))
#define XB_XSUB(j)  (1280 + 64 * (j))
#define XB_XGEN(j)  (2304 + 64 * (j))
#define XB_TOP      3328
#define XB_TOPGEN   3392
#define XCD_BAR_WORDS 3456
#define XB_SPIN_CAP (1u << 18)

__device__ __forceinline__ unsigned xb_ld(unsigned* p)              { return __hip_atomic_load(p, __ATOMIC_RELAXED, __HIP_MEMORY_SCOPE_AGENT); }
__device__ __forceinline__ unsigned xb_add(unsigned* p, unsigned v) { return __hip_atomic_fetch_add(p, v, __ATOMIC_RELAXED, __HIP_MEMORY_SCOPE_AGENT); }
__device__ __forceinline__ unsigned xb_xcc_id() { return (unsigned)__builtin_amdgcn_s_getreg((3 << 11) | 20) & 0xFu; }
#define XB_SPIN(cond, bar) do { unsigned _sp = 0; while (cond) { __builtin_amdgcn_s_sleep(1); \
    if ((++_sp & 255u) == 0u) { if (xb_ld(&(bar)[XB_TMO])) break; if (_sp > XB_SPIN_CAP) { atomicAdd(&(bar)[XB_TMO], 1u); break; } } } } while (0)

struct XcdBarrier {
    unsigned* bar; unsigned x;
    volatile LAS unsigned* st;
};

__device__ __forceinline__ XcdBarrier xcd_barrier_post(unsigned* bar, volatile LAS unsigned* st) {
    XcdBarrier b; b.bar = bar; b.x = xb_xcc_id(); b.st = st;
    if (threadIdx.x == 0) (void)xb_add(&bar[XB_XCNT(b.x)], 1u);
    return b;
}
__device__ __forceinline__ void xcd_barrier_complete(unsigned* bar, unsigned x, unsigned& nloc, unsigned& nx) {
    const unsigned G = gridDim.x * gridDim.y * gridDim.z;
    unsigned sum, cnt, mine, sp = 0u;
    for (;;) {
        sum = 0u; cnt = 0u; mine = 0u;
#pragma unroll
        for (unsigned j = 0; j < 16; ++j) { const unsigned c = xb_ld(&bar[XB_XCNT(j)]); sum += c; cnt += (c > 0u) ? 1u : 0u; mine = (j == x) ? c : mine; }
        if (sum == G) break;
        __builtin_amdgcn_s_sleep(1);
        if ((++sp & 255u) == 0u) { if (xb_ld(&bar[XB_TMO])) break; if (sp > XB_SPIN_CAP) { atomicAdd(&bar[XB_TMO], 1u); break; } }
    }
    nloc = mine > 0u ? mine : 1u; nx = cnt > 0u ? cnt : 1u;
}

__device__ __forceinline__ void xcd_barrier(const XcdBarrier& b) {
    asm volatile("s_waitcnt vmcnt(0)" ::: "memory");
    __syncthreads();
    if (threadIdx.x == 0) {
        unsigned* bar = b.bar;
        __builtin_amdgcn_s_waitcnt(0);
        unsigned nloc = b.st[0], nx = b.st[1];
        if (nloc == 0u) { xcd_barrier_complete(bar, b.x, nloc, nx); b.st[0] = nloc; b.st[1] = nx; }
        const unsigned old = xb_add(&bar[XB_XSUB(b.x)], 1u);
        const unsigned gen = old / nloc;
        if (old + 1u == (gen + 1u) * nloc) {
            __builtin_amdgcn_fence(__ATOMIC_RELEASE, "agent");
            asm volatile("s_waitcnt vmcnt(0)" ::: "memory");
            const unsigned og = xb_add(&bar[XB_TOP], 1u);
            const unsigned tg = og / nx;
            if (og + 1u == (tg + 1u) * nx) xb_add(&bar[XB_TOPGEN], 1u);
            else XB_SPIN(xb_ld(&bar[XB_TOPGEN]) == tg, bar);
            __builtin_amdgcn_fence(__ATOMIC_ACQUIRE, "agent");
            xb_add(&bar[XB_XGEN(b.x)], 1u);
            asm volatile("s_waitcnt vmcnt(0)" ::: "memory");
        } else {
            XB_SPIN(xb_ld(&bar[XB_XGEN(b.x)]) == gen, bar);
            __builtin_amdgcn_fence(__ATOMIC_ACQUIRE, "agent");
            asm volatile("s_waitcnt vmcnt(0)" ::: "memory");
        }
    }
    __syncthreads();
}
constexpr int NWAVES = 8;
constexpr int RING_OFF = 0, RING_BYTES = 147456;
constexpr int MISC_OFF = RING_BYTES;
constexpr int LDS_BYTES = 151552;
typedef float f32x2 __attribute__((ext_vector_type(2)));
typedef unsigned u32x2 __attribute__((ext_vector_type(2)));

__device__ __forceinline__ float wave_sum(float v) {
#pragma unroll
    for (int o = 1; o < 64; o <<= 1) v += __shfl_xor(v, o);
    return v;
}
__device__ __forceinline__ float sigmoidf_(float x) { return 1.0f / (1.0f + __expf(-x)); }
__device__ __forceinline__ float siluf_(float x) { return x / (1.0f + __expf(-x)); }
__device__ __forceinline__ float gelu_tanh(float x) { const float u = 0.7978845608028654f * (x + 0.044715f * x * x * x); const float e = __expf(2.0f * u); const float th = 1.0f - 2.0f / (e + 1.0f); return 0.5f * x * (1.0f + th); }

__device__ __forceinline__ void tr_item(const float* W, int ldw, int k0, int n0, int nvalid, bf16* dst, int dld, int drow0, LAS float* scr, int lane) {
    const int nn = lane & 31;
#pragma unroll 8
    for (int i = 0; i < 32; ++i) { const int kk = 2 * i + (lane >> 5); scr[kk * 33 + nn] = (nn < nvalid) ? W[(size_t)(k0 + kk) * ldw + n0 + nn] : 0.f; }
    LDS_WAIT(); asm volatile("" ::: "memory");
    const int c = lane & 7;
#pragma unroll
    for (int j = 0; j < 4; ++j) { const int n = (lane >> 3) + 8 * j; const LAS float* s = scr + (8 * c) * 33 + n;
        v4u o; o.x = pk2(s[0 * 33], s[1 * 33]); o.y = pk2(s[2 * 33], s[3 * 33]); o.z = pk2(s[4 * 33], s[5 * 33]); o.w = pk2(s[6 * 33], s[7 * 33]);
        if (n < nvalid) *(GAS v4u*)(dst + (size_t)(drow0 + n) * dld + k0 + 8 * c) = o; }
    LDS_WAIT(); asm volatile("" ::: "memory");
}
struct P0Args { const float *c, *w_in, *ck_w1, *cv_w1, *ck_pos, *cv_pos, *w_out0, *w_q1, *w_kv, *w_out1, *moe_g, *moe_u, *moe_d, *ada_w, *ada_b; unsigned char* ws; };
__device__ __forceinline__ void p0_transposes(const P0Args& a, LAS unsigned char* lds, int gw, int ngw, int wave, int lane) {
    LAS float* scr = (LAS float*)(lds + 49152 + wave * 8704);
    constexpr int I_WIN = 16 * 82, I_CW = 512, I_SQ = 512, I_KV = 256, I_MOE = 4096;
    constexpr int NITEMS = I_WIN + I_CW + 3 * I_SQ + I_KV + 3 * I_MOE;
    unsigned char* ws = a.ws;
    for (int it = gw; it < NITEMS; it += ngw) {
        int r = it;
        if (r < I_WIN) { const int kb = r / 82, nb = r % 82; const int n0 = nb * 32; const int nv = (NSA_IN - n0) < 32 ? (NSA_IN - n0) : 32;
            tr_item(a.w_in, NSA_IN, kb * 64, n0, nv, (bf16*)(ws + WS_WIN), 1024, n0, scr, lane); continue; } r -= I_WIN;
        if (r < I_CW) { const int tz = r >> 8, hf = (r >> 7) & 1, q = r & 127, kb = q >> 3, nb = q & 7;
            const float* W = (tz ? a.cv_w1 : a.ck_w1) + (size_t)hf * 1024 * 256;
            tr_item(W, 256, kb * 64, nb * 32, 32, (bf16*)(ws + WS_CW1) + (size_t)tz * 512 * 1024, 1024, hf * 256 + nb * 32, scr, lane); continue; } r -= I_CW;
        if (r < I_SQ) { tr_item(a.w_out0, 1024, (r >> 5) * 64, (r & 31) * 32, 32, (bf16*)(ws + WS_WOUT0), 1024, (r & 31) * 32, scr, lane); continue; } r -= I_SQ;
        if (r < I_SQ) { tr_item(a.w_q1, 1024, (r >> 5) * 64, (r & 31) * 32, 32, (bf16*)(ws + WS_WQ1), 1024, (r & 31) * 32, scr, lane); continue; } r -= I_SQ;
        if (r < I_KV) { tr_item(a.w_kv, 512, (r >> 4) * 64, (r & 15) * 32, 32, (bf16*)(ws + WS_WKV), 1024, (r & 15) * 32, scr, lane); continue; } r -= I_KV;
        if (r < I_SQ) { tr_item(a.w_out1, 1024, (r >> 5) * 64, (r & 31) * 32, 32, (bf16*)(ws + WS_WOUT1), 1024, (r & 31) * 32, scr, lane); continue; } r -= I_SQ;
        if (r < 2 * I_MOE) { const int up = r >= I_MOE; const int q = up ? r - I_MOE : r; const int le = q >> 7, w = q & 127, kb = w >> 3, nb = w & 7; const int n0 = nb * 32;
            const float* W = (up ? a.moe_u : a.moe_g) + (size_t)le * 1024 * 256;
            tr_item(W, 256, kb * 64, n0, 32, (bf16*)(ws + WS_WGU) + (size_t)le * 512 * 1024, 1024, (n0 >> 7) * 256 + (up ? 128 : 0) + (n0 & 127), scr, lane); continue; } r -= 2 * I_MOE;
        { const int le = r >> 7, w = r & 127, kb = w >> 5, nb = w & 31;
            tr_item(a.moe_d + (size_t)le * 256 * 1024, 1024, kb * 64, nb * 32, 32, (bf16*)(ws + WS_WD) + (size_t)le * 1024 * 256, 256, nb * 32, scr, lane); }
    }
}
__device__ __forceinline__ void p0_small(const P0Args& a, LAS unsigned char* lds, int blk, int nblk, int tid) {
    LAS float* cond = (LAS float*)lds;
    LAS float* part = (LAS float*)(lds + 32768);
    const int col = tid & 63, ks = tid >> 6;
    for (int u = blk; u < 200 + 26; u += nblk) {
        if (u < 192) {
            for (int i = tid; i < 8192; i += 512) cond[i] = siluf_(a.c[i]);
            __syncthreads();
            const int layer = u / 96, c0 = (u % 96) * 64;
            const float* W = a.ada_w + (size_t)layer * 1024 * 6144 + c0 + col;
            float acc[8];
#pragma unroll
            for (int b = 0; b < 8; ++b) acc[b] = 0.f;
#pragma unroll 8
            for (int k = ks * 128; k < ks * 128 + 128; ++k) { const float w = W[(size_t)k * 6144];
#pragma unroll
                for (int b = 0; b < 8; ++b) acc[b] += cond[b * 1024 + k] * w; }
#pragma unroll
            for (int b = 0; b < 8; ++b) part[(ks * 8 + b) * 64 + col] = acc[b];
            __syncthreads();
            { const int b = tid >> 6; float s = 0.f;
#pragma unroll
              for (int k2 = 0; k2 < 8; ++k2) s += part[(k2 * 8 + b) * 64 + col];
              ((float*)(a.ws + WS_ADA))[(size_t)(layer * 8 + b) * 6144 + c0 + col] = s + a.ada_b[layer * 6144 + c0 + col]; }
            __syncthreads();
        } else if (u < 200) {
            const int tz = (u - 192) >> 2, c0 = ((u - 192) & 3) * 64;
            const float* W = (tz ? a.cv_w1 : a.ck_w1) + c0 + col; const float* pos = tz ? a.cv_pos : a.ck_pos;
            float acc = 0.f;
#pragma unroll 8
            for (int k = ks * 256; k < ks * 256 + 256; ++k) acc += pos[k] * W[(size_t)k * 256];
            part[ks * 64 + col] = acc;
            __syncthreads();
            if (tid < 64) { float s = 0.f;
#pragma unroll
                for (int k2 = 0; k2 < 8; ++k2) s += part[k2 * 64 + tid];
                ((float*)(a.ws + WS_POSB))[tz * 256 + c0 + tid] = s; }
            __syncthreads();
        } else {
            const int sl = u - 200; GAS v4u* p = (GAS v4u*)(a.ws + WS_WIN + (size_t)NSA_IN * 2048) + sl * 1024;
            for (int i = tid; i < 1024; i += 512) p[i] = (v4u){0u, 0u, 0u, 0u};
        }
    }
}

struct RowVec { f32x4 v[4]; };
__device__ __forceinline__ RowVec ld_row_f32(const float* p, int lane) { RowVec r; const GAS f32x4* q = (const GAS f32x4*)p + lane;
#pragma unroll
    for (int j = 0; j < 4; ++j) r.v[j] = q[64 * j]; return r; }
__device__ __forceinline__ void st_row_f32(float* p, int lane, const RowVec& r) { GAS f32x4* q = (GAS f32x4*)p + lane;
#pragma unroll
    for (int j = 0; j < 4; ++j) q[64 * j] = r.v[j]; }
__device__ __forceinline__ RowVec ld_row_bf16(const bf16* p, int lane) { RowVec r; const GAS u32x2* q = (const GAS u32x2*)p + lane;
#pragma unroll
    for (int j = 0; j < 4; ++j) { const u32x2 w = q[64 * j]; r.v[j] = (f32x4){__uint_as_float(w.x << 16), __uint_as_float(w.x & 0xffff0000u), __uint_as_float(w.y << 16), __uint_as_float(w.y & 0xffff0000u)}; } return r; }
__device__ __forceinline__ void st_row_bf16(bf16* p, int lane, const RowVec& r) { GAS u32x2* q = (GAS u32x2*)p + lane;
#pragma unroll
    for (int j = 0; j < 4; ++j) { u32x2 w; w.x = pg8::cvt_pk_bf16(r.v[j].x, r.v[j].y); w.y = pg8::cvt_pk_bf16(r.v[j].z, r.v[j].w); q[64 * j] = w; } }
__device__ __forceinline__ RowVec layer_norm_row(const RowVec& in, const RowVec& g, const RowVec& b) {
    float s = 0.f;
#pragma unroll
    for (int j = 0; j < 4; ++j) s += (in.v[j].x + in.v[j].y) + (in.v[j].z + in.v[j].w);
    const float mean = wave_sum(s) * (1.f / DM); float s2 = 0.f; RowVec d;
#pragma unroll
    for (int j = 0; j < 4; ++j) { d.v[j] = in.v[j] - mean; s2 += (d.v[j].x * d.v[j].x + d.v[j].y * d.v[j].y) + (d.v[j].z * d.v[j].z + d.v[j].w * d.v[j].w); }
    const float rstd = 1.f / sqrtf(wave_sum(s2) * (1.f / DM) + LN_EPS_F);
#pragma unroll
    for (int j = 0; j < 4; ++j) d.v[j] = d.v[j] * rstd * g.v[j] + b.v[j];
    return d;
}
__device__ __forceinline__ const float* ada_vec(const unsigned char* ws, int layer, int b, int k) { return (const float*)(ws + WS_ADA) + (size_t)(layer * 8 + b) * 6144 + k * 1024; }

__device__ __forceinline__ void p_modulate(const float* x, unsigned char* ws, int layer, bf16* hb, int gw, int ngw, int lane) {
    const int rpw = NT / ngw;
    const int r0 = gw * rpw, b = r0 >> 12;
    const RowVec sh = ld_row_f32(ada_vec(ws, layer, b, 0), lane), sc = ld_row_f32(ada_vec(ws, layer, b, 1), lane);
    for (int m = r0; m < r0 + rpw; ++m) { RowVec v = ld_row_f32(x + (size_t)m * DM, lane);
#pragma unroll
        for (int j = 0; j < 4; ++j) v.v[j] = v.v[j] * (1.0f + sc.v[j]) + sh.v[j];
        st_row_bf16(hb + (size_t)m * DM, lane, v); }
}

struct LnRouterArgs { const float* xin; const bf16* xinb; const bf16* mix; bf16* x1b; bf16* h2; const float* ln_g; const float* ln_b; const float* router_w; const float* router_b; unsigned char* ws; int layer; unsigned* cnt; };
template <bool XBF> __device__ __forceinline__ void p_ln_router(const LnRouterArgs& a, LAS unsigned char* lds, int blk, int nblk, int tid) {
    typedef float f32x4v __attribute__((ext_vector_type(4)));
    const int lane = tid & 63, wave = __builtin_amdgcn_readfirstlane(tid >> 6);
    LAS float* Tt = (LAS float*)lds;
    LAS float* Pp = (LAS float*)(lds + 66048);
    LAS float* Ss = (LAS float*)(lds + 66048 + 8192);
    LAS unsigned* tokE = (LAS unsigned*)(lds + 66048 + 8192 + 1024);
    LAS unsigned* lcnt = tokE + 256;
    LAS unsigned* lbase = lcnt + 16;
    LAS float* rbl = (LAS float*)(lbase + 16);
    const int rows_per_blk = NT / nblk;
    const int row0 = blk * rows_per_blk, b = row0 >> 12;
    if (tid < 16) { lcnt[tid] = 0u; rbl[tid] = a.router_b[tid]; }
    float wreg[32];
#pragma unroll
    for (int i = 0; i < 32; ++i) wreg[i] = a.router_w[(size_t)(128 * wave + 4 * i + (lane >> 4)) * 16 + (lane & 15)];
    const RowVec ga = ld_row_f32(ada_vec(a.ws, a.layer, b, 2), lane), shf = ld_row_f32(ada_vec(a.ws, a.layer, b, 3), lane), scf = ld_row_f32(ada_vec(a.ws, a.layer, b, 4), lane);
    const RowVec lg = ld_row_f32(a.ln_g, lane), lb = ld_row_f32(a.ln_b, lane);
    float* tokw = (float*)(a.ws + WS_TOKW);
    RowVec nx[XBF ? 1 : 2]; u32x2 nxb[XBF ? 2 : 1][4]; u32x2 nmr[2][4];
#define LNR_LOAD(G0) _Pragma("unroll") for (int rr = 0; rr < 2; ++rr) { const size_t m_ = (size_t)((G0) + 2 * wave + rr); \
        if (XBF) { const GAS u32x2* x_ = (const GAS u32x2*)(a.xinb + m_ * DM) + lane; _Pragma("unroll") for (int j = 0; j < 4; ++j) nxb[XBF ? rr : 0][j] = x_[64 * j]; } else nx[XBF ? 0 : rr] = ld_row_f32(a.xin + m_ * DM, lane); \
        const GAS u32x2* q_ = (const GAS u32x2*)(a.mix + m_ * DM) + lane; _Pragma("unroll") for (int j = 0; j < 4; ++j) nmr[rr][j] = q_[64 * j]; }
    LNR_LOAD(row0)
    for (int grp = 0; grp < rows_per_blk / 16; ++grp) {
        const int g0 = row0 + grp * 16;
#pragma unroll
        for (int rr = 0; rr < 2; ++rr) { const int lr = 2 * wave + rr; const size_t m = (size_t)(g0 + lr);
            RowVec xv, mv;
            if (XBF) {
#pragma unroll
                for (int j = 0; j < 4; ++j) { const u32x2 w = nxb[XBF ? rr : 0][j]; xv.v[j] = (f32x4){__uint_as_float(w.x << 16), __uint_as_float(w.x & 0xffff0000u), __uint_as_float(w.y << 16), __uint_as_float(w.y & 0xffff0000u)}; }
            } else xv = nx[XBF ? 0 : rr];
#pragma unroll
            for (int j = 0; j < 4; ++j) { const u32x2 w = nmr[rr][j]; mv.v[j] = (f32x4){__uint_as_float(w.x << 16), __uint_as_float(w.x & 0xffff0000u), __uint_as_float(w.y << 16), __uint_as_float(w.y & 0xffff0000u)}; }
#pragma unroll
            for (int j = 0; j < 4; ++j) xv.v[j] = ALPHA_F * xv.v[j] + (1.0f + ga.v[j]) * mv.v[j];
            RowVec y = layer_norm_row(xv, lg, lb);
            st_row_bf16(a.x1b + m * DM, lane, y);
#pragma unroll
            for (int j = 0; j < 4; ++j) y.v[j] = y.v[j] * (1.0f + scf.v[j]) + shf.v[j];
            st_row_bf16(a.h2 + m * DM, lane, y);
#pragma unroll
            for (int j = 0; j < 4; ++j) *(LAS f32x4v*)(Tt + lr * 1028 + 4 * lane + 256 * j) = y.v[j];
        }
        if (grp + 1 < rows_per_blk / 16) { LNR_LOAD(g0 + 16) }
        __syncthreads();
        { f32x4v acc = {0.f, 0.f, 0.f, 0.f}; const LAS float* ap = Tt + (lane & 15) * 1028 + 128 * wave + (lane >> 4);
#pragma unroll
          for (int i = 0; i < 32; ++i) acc = __builtin_amdgcn_mfma_f32_16x16x4f32(ap[4 * i], wreg[i], acc, 0, 0, 0);
#pragma unroll
          for (int r = 0; r < 4; ++r) Pp[(wave * 16 + 4 * (lane >> 4) + r) * 16 + (lane & 15)] = acc[r]; }
        __syncthreads();
        if (tid < 256) { float s = 0.f;
#pragma unroll
            for (int w = 0; w < 8; ++w) s += Pp[w * 256 + tid];
            Ss[tid] = sigmoidf_(s); }
        __syncthreads();
        if (tid < 16) {
            float ba = -INFINITY, bb = 0.f, bsa = 0.f, bsb = 0.f, best = -INFINITY; int bia = 0, bib = 0;
#pragma unroll
            for (int gi = 0; gi < 4; ++gi) { float va = -INFINITY, vb = -INFINITY, sa = 0.f, sb = 0.f; int ia = 0, ib = 0;
#pragma unroll
                for (int q = 0; q < 4; ++q) { const int e = 4 * gi + q; const float s = Ss[tid * 16 + e]; const float v = s + rbl[e];
                    if (v > va) { vb = va; ib = ia; sb = sa; va = v; ia = e; sa = s; } else if (v > vb) { vb = v; ib = e; sb = s; } }
                const float gs = va + vb;
                if (gs > best) { best = gs; ba = va; bb = vb; bia = ia; bib = ib; bsa = sa; bsb = sb; } }
            (void)ba; (void)bb;
            const float inv = 1.0f / (bsa + bsb); const int m = g0 + tid;
            tokw[(size_t)m * 2 + 0] = bsa * inv; tokw[(size_t)m * 2 + 1] = bsb * inv;
            const unsigned p0 = atomicAdd((unsigned*)&lcnt[bia], 1u), p1 = atomicAdd((unsigned*)&lcnt[bib], 1u);
            tokE[(grp * 16 + tid) * 2 + 0] = (unsigned)bia | (p0 << 8); tokE[(grp * 16 + tid) * 2 + 1] = (unsigned)bib | (p1 << 8);
        }
        __syncthreads();
    }
    if (tid < 16) lbase[tid] = __hip_atomic_fetch_add(a.cnt + tid, lcnt[tid], __ATOMIC_RELAXED, __HIP_MEMORY_SCOPE_AGENT);
    __syncthreads();
    if (tid < 2 * rows_per_blk) { const unsigned en = tokE[tid]; const unsigned e = en & 255u, lp = en >> 8;
        const unsigned tk = (unsigned)(row0 + (tid >> 1)) * 2u + (unsigned)(tid & 1);
        ((unsigned*)(a.ws + WS_LIST))[(size_t)e * NT + lbase[e] + lp] = tk;
        ((unsigned*)(a.ws + WS_TOKPOS))[tk] = e | ((lbase[e] + lp) << 8); }
    __syncthreads();
}

#undef LNR_LOAD
template <bool FINAL> __device__ __forceinline__ void p_ln_ffn(const float* xin, const bf16* xinb, float* xout, const bf16* mix, const unsigned char* y, const float* ln_g1, const float* ln_b1, const float* ln_g_, const float* ln_b_, unsigned char* ws, int layer, bf16* xb, bf16* hb, const unsigned* cnt, LAS unsigned char* lds, int gw, int ngw, int tid) {
    constexpr bool prep = !FINAL;
    const int lane = tid & 63;
    LAS int* tb = (LAS int*)lds;
    if (tid < 16) { int base = 0; for (int e = 0; e < tid; ++e) base += ((int)cnt[e] + 255) >> 8; tb[tid] = base; }
    __syncthreads();
    const int rpw = NT / ngw; const int r0 = gw * rpw, b = r0 >> 12;
    const RowVec gf = ld_row_f32(ada_vec(ws, layer, b, 5), lane), lg = ld_row_f32(ln_g_, lane), lb = ld_row_f32(ln_b_, lane);
    RowVec sh, sc;
    if (prep) { sh = ld_row_f32(ada_vec(ws, layer + 1, b, 0), lane); sc = ld_row_f32(ada_vec(ws, layer + 1, b, 1), lane); }
    const unsigned* tokpos = (const unsigned*)(ws + WS_TOKPOS); const float* tokw_ = (const float*)(ws + WS_TOKW);
    const int li = lane < 2 * rpw ? lane : 0; const unsigned tpv = tokpos[2 * r0 + li]; const float twv = tokw_[2 * r0 + li];
    const unsigned yrow_l = (unsigned)tb[tpv & 255u] * 256u + (tpv >> 8);
    struct RowIn { u32x2 xr[4]; unsigned ya[4], yb[4]; };
    auto load_row = [&](int k) { RowIn r; const int m = r0 + k;
        const unsigned y0 = (unsigned)__builtin_amdgcn_readlane((int)yrow_l, 2 * k), y1 = (unsigned)__builtin_amdgcn_readlane((int)yrow_l, 2 * k + 1);
        const GAS u32x2* xp = (const GAS u32x2*)(xinb + (size_t)m * DM) + lane;
        const GAS unsigned* ap = (const GAS unsigned*)(y + (size_t)y0 * DM) + lane; const GAS unsigned* bp = (const GAS unsigned*)(y + (size_t)y1 * DM) + lane;
#pragma unroll
        for (int j = 0; j < 4; ++j) { r.xr[j] = xp[64 * j]; r.ya[j] = ap[64 * j]; r.yb[j] = bp[64 * j]; }
        return r; };
#define F8x4(w_) ([](unsigned q_) { const auto lo_ = __builtin_amdgcn_cvt_pk_f32_fp8((int)q_, false); const auto hi_ = __builtin_amdgcn_cvt_pk_f32_fp8((int)q_, true); return (f32x4){lo_[0], lo_[1], hi_[0], hi_[1]}; }(w_))
#define BF4(w_) ((f32x4){__uint_as_float((w_).x << 16), __uint_as_float((w_).x & 0xffff0000u), __uint_as_float((w_).y << 16), __uint_as_float((w_).y & 0xffff0000u)})
    RowIn cur = load_row(0);
#pragma unroll 1
    for (int k = 0; k < rpw; ++k) {
        RowIn nxt = cur; if (k + 1 < rpw) nxt = load_row(k + 1);
        const int m = r0 + k;
        const float w0 = __int_as_float(__builtin_amdgcn_readlane(__float_as_int(twv), 2 * k)), w1 = __int_as_float(__builtin_amdgcn_readlane(__float_as_int(twv), 2 * k + 1));
        RowVec xv;
#pragma unroll
        for (int j = 0; j < 4; ++j) xv.v[j] = ALPHA_F * BF4(cur.xr[j]) + (1.0f + gf.v[j]) * (w0 * F8x4(cur.ya[j]) + w1 * F8x4(cur.yb[j]));
        RowVec yv = layer_norm_row(xv, lg, lb);
        if (FINAL) st_row_f32(xout + (size_t)m * DM, lane, yv);
        if (prep) { st_row_bf16(xb + (size_t)m * DM, lane, yv);
#pragma unroll
            for (int j = 0; j < 4; ++j) yv.v[j] = yv.v[j] * (1.0f + sc.v[j]) + sh.v[j];
            st_row_bf16(hb + (size_t)m * DM, lane, yv); }
        cur = nxt;
    }
#undef BF4
#undef F8x4
    __syncthreads();
}

__device__ __forceinline__ void p_cmp_tail(const float* w2k, const float* w2v, unsigned char* ws, LAS unsigned char* lds, int blk, int nblk, int tid) {
    typedef float f32x4v __attribute__((ext_vector_type(4)));
    LAS float* W2 = (LAS float*)lds;
    LAS float* Hd = (LAS float*)(lds + 65536);
    const float* UL = (const float*)(ws + WS_UL);
    for (int u = blk; u < 512; u += nblk) {
        const int tz = u >> 8, bg = (u >> 3) & 31, ch = u & 7;
        const float* w2 = tz ? w2v : w2k; const float* posb = (const float*)(ws + WS_POSB) + tz * 256;
        for (int i = tid; i < 4096; i += 512) *(LAS f32x4v*)(W2 + 4 * i) = *(const GAS f32x4v*)(w2 + 4 * i);
        for (int i = tid; i < 32 * 64; i += 512) { const int n = i >> 6, c4 = (i & 63) * 4; const int nn = ch * 32 + n; const size_t R = (size_t)tz * 8192 + bg * 256 + nn;
            f32x4v h = {0.f, 0.f, 0.f, 0.f};
            if (nn < 255) { const f32x4v uu = *(const GAS f32x4v*)(UL + R * 512 + c4), ll = *(const GAS f32x4v*)(UL + (R + 1) * 512 + 256 + c4), pb = *(const GAS f32x4v*)(posb + c4);
                h.x = gelu_tanh(uu.x + ll.x + pb.x); h.y = gelu_tanh(uu.y + ll.y + pb.y); h.z = gelu_tanh(uu.z + ll.z + pb.z); h.w = gelu_tanh(uu.w + ll.w + pb.w); }
            *(LAS f32x4v*)(Hd + n * 260 + c4) = h; }
        __syncthreads();
        { const int n = tid >> 4, dq = tid & 15; f32x4v acc = {0.f, 0.f, 0.f, 0.f};
#pragma unroll 8
          for (int c = 0; c < 256; ++c) { const float h = Hd[n * 260 + c]; const f32x4v w = *(const LAS f32x4v*)(W2 + c * 64 + 4 * dq); acc += h * w; }
          bf16* dst = (bf16*)(ws + (tz ? WS_VCMP : WS_KCMP)) + ((size_t)bg * 256 + ch * 32 + n) * 64 + 4 * dq;
          u32x2 o; o.x = pk2(acc.x, acc.y); o.y = pk2(acc.z, acc.w); *(GAS u32x2*)dst = o; }
        __syncthreads();
    }
}

namespace att {
typedef float f32x16 __attribute__((ext_vector_type(16)));
typedef short s16x4 __attribute__((ext_vector_type(4)));
constexpr int NSLOT = 6, SLOT_B = 16384;
constexpr int TSZ = 640;
constexpr int L_RING = 0, L_TB = NSLOT * SLOT_B, L_P4 = L_TB + TSZ * 8, L_P3 = L_P4 + 16384, L_SEL = L_P3 + 16384, L_NEXT = L_SEL + 512, L_END = L_NEXT + 16;
static_assert(L_END <= RING_BYTES, "attention LDS");
constexpr unsigned short TB_MASK = 0xF14Au;
constexpr float MASK_TEST = -1e29f;
constexpr float THR = 8.0f;
__device__ const unsigned char BUCKET[129] = {0, 1, 2, 3, 4, 5, 6, 7, 8, 9, 10, 11, 12, 13, 14, 15, 16, 16, 16, 17, 17, 18, 18, 18, 19, 19, 19, 20, 20, 20, 20, 21, 21, 21, 21, 22, 22, 22, 22, 22, 23, 23, 23, 23, 23, 23, 24, 24, 24, 24, 24, 24, 25, 25, 25, 25, 25, 25, 25, 26, 26, 26, 26, 26, 26, 26, 26, 27, 27, 27, 27, 27, 27, 27, 27, 27, 27, 28, 28, 28, 28, 28, 28, 28, 28, 28, 28, 29, 29, 29, 29, 29, 29, 29, 29, 29, 29, 29, 29, 30, 30, 30, 30, 30, 30, 30, 30, 30, 30, 30, 30, 30, 30, 31, 31, 31, 31, 31, 31, 31, 31, 31, 31, 31, 31, 31, 31, 31, 31};
__device__ __forceinline__ int crow(int r, int hi) { return (r & 3) + 8 * (r >> 2) + 4 * hi; }
__device__ __forceinline__ int med3i(int a, int lo, int hi) { return a < lo ? lo : (a > hi ? hi : a); }
__device__ __forceinline__ s16x4 vtr(const LAS unsigned char* p) { return __builtin_bit_cast(s16x4, __builtin_amdgcn_ds_read_tr16_b64_v4i16((LAS s16x4*)p)); }
__device__ __forceinline__ unsigned cvtpk(float lo, float hi) { return pg8::cvt_pk_bf16(lo, hi); }
__device__ __forceinline__ float fadd_s(float a, float b) { float r; asm("v_add_f32_e32 %0, %1, %2" : "=v"(r) : "v"(a), "v"(b)); return r; }
__device__ __forceinline__ float max3f(float a, float b, float c) { return __builtin_fmaxf(__builtin_fmaxf(a, b), c); }
__device__ __forceinline__ void glds16(const void* gsrc, unsigned lds_dst) { unsigned keep;
    asm volatile("s_mov_b32 %0, m0\n\ts_mov_b32 m0, %2\n\ts_nop 0\n\tglobal_load_lds_dwordx4 %1, off\n\ts_mov_b32 m0, %0" : "=&s"(keep) : "v"(gsrc), "s"(lds_dst) : "memory"); }
#define ATT_WAIT_BAR(N) asm volatile("s_waitcnt vmcnt(" #N ") lgkmcnt(0)\n\ts_barrier" ::: "memory")

struct LaneGeo {
    int lane, wid, r32, hi;
    unsigned dma_off;
    unsigned dma_dst;
    int koff[4];
    int voff[2][2];
    static __device__ __forceinline__ int fsw(int row) { return (((row >> 1) & 1) << 2) | ((row >> 2) & 3); }
    __device__ __forceinline__ void init(int tid) {
        lane = tid & 63; wid = __builtin_amdgcn_readfirstlane(tid >> 6); r32 = lane & 31; hi = lane >> 5;
        const int rr = lane >> 3, cc = lane & 7, row = 8 * wid + rr;
        dma_off = (unsigned)(row * 128 + ((cc ^ fsw(row)) * 16));
        dma_dst = (unsigned)(wid * 1024);
#pragma unroll
        for (int d0 = 0; d0 < 4; ++d0) koff[d0] = r32 * 128 + (((2 * d0 + hi) ^ fsw(r32)) * 16);
        const int i16 = lane & 15, g4 = lane >> 4, hh = g4 >> 1, rowl = 4 * hh + (i16 >> 2), ch0 = 2 * (g4 & 1) + ((i16 & 3) >> 1);
#pragma unroll
        for (int dh = 0; dh < 2; ++dh)
#pragma unroll
            for (int t = 0; t < 2; ++t) voff[dh][t] = (8 * t + rowl) * 128 + ((((ch0 + 4 * dh) ^ fsw(8 * t + rowl)) * 16) + 8 * (i16 & 1));
    }
};
__device__ __forceinline__ void dma_tile(const LaneGeo& L, const bf16* gK, const bf16* gV, unsigned lds0, int slot) {
    const unsigned dst = (unsigned)__builtin_amdgcn_readfirstlane((int)(lds0 + L_RING + slot * SLOT_B + L.dma_dst));
    glds16((const char*)gK + L.dma_off, dst); glds16((const char*)gV + L.dma_off, dst + 8192u);
}
__device__ __forceinline__ void qk_tile(f32x16& p0, f32x16& p1, const LAS unsigned char* Ks, const bf16x8 (&qr)[4], const LaneGeo& L, const f32x16& c) {
    bf16x8 a0[4], a1[4];
#pragma unroll
    for (int d0 = 0; d0 < 4; ++d0) { a0[d0] = *(const LAS bf16x8*)(Ks + L.koff[d0]); a1[d0] = *(const LAS bf16x8*)(Ks + L.koff[d0] + 4096); }
    __builtin_amdgcn_s_setprio(1);
    p0 = __builtin_amdgcn_mfma_f32_32x32x16_bf16(a0[0], qr[0], c, 0, 0, 0); p1 = __builtin_amdgcn_mfma_f32_32x32x16_bf16(a1[0], qr[0], c, 0, 0, 0);
#pragma unroll
    for (int d0 = 1; d0 < 4; ++d0) { p0 = __builtin_amdgcn_mfma_f32_32x32x16_bf16(a0[d0], qr[d0], p0, 0, 0, 0); p1 = __builtin_amdgcn_mfma_f32_32x32x16_bf16(a1[d0], qr[d0], p1, 0, 0, 0); }
    __builtin_amdgcn_s_setprio(0);
}
__device__ __forceinline__ float quad_sum(float v) {
    v += __int_as_float(__builtin_amdgcn_mov_dpp(__float_as_int(v), 0xB1, 0xF, 0xF, true));
    v += __int_as_float(__builtin_amdgcn_mov_dpp(__float_as_int(v), 0x4E, 0xF, 0xF, true));
    return v;
}
__device__ __forceinline__ float xhalf_max(float v) { auto rr = __builtin_amdgcn_permlane32_swap(__float_as_uint(v), __float_as_uint(v), false, false); return __builtin_fmaxf(__uint_as_float(rr[0]), __uint_as_float(rr[1])); }
__device__ __forceinline__ float xhalf_sum(float v) { auto rr = __builtin_amdgcn_permlane32_swap(__float_as_uint(v), __float_as_uint(v), false, false); return __uint_as_float(rr[0]) + __uint_as_float(rr[1]); }
__device__ __forceinline__ void softmax_pv(f32x16& p0, f32x16& p1, const LAS unsigned char* Vs, f32x16 (&o)[2], float& m, float& l, f32x16& cini, bool rowok, const LaneGeo& L) {
    float a = max3f(p0[0], p0[1], p1[0]), b = max3f(p0[2], p0[3], p1[1]); a = max3f(a, p1[2], p1[3]);
#pragma unroll
    for (int r = 4; r < 16; r += 4) { a = max3f(a, p0[r], p0[r + 1]); b = max3f(b, p0[r + 2], p0[r + 3]); a = max3f(a, p1[r], p1[r + 1]); b = max3f(b, p1[r + 2], p1[r + 3]); }
    const float mx = xhalf_max(__builtin_fmaxf(a, b));
    const bool grow = rowok && ((mx > THR) || (l == 0.f && mx > MASK_TEST));
    if (__builtin_expect(__any(grow), 0)) {
        const float dl = grow ? mx : 0.f; m += dl; const float f = __builtin_amdgcn_exp2f(-dl); l *= f;
#pragma unroll
        for (int r = 0; r < 16; ++r) { p0[r] -= dl; p1[r] -= dl; o[0][r] *= f; o[1][r] *= f; cini[r] -= dl; }
    }
    float rs0 = 0.f, rs1 = 0.f;
#pragma unroll
    for (int r = 0; r < 16; ++r) { p0[r] = __builtin_amdgcn_exp2f(p0[r]); p1[r] = __builtin_amdgcn_exp2f(p1[r]); rs0 += p0[r]; rs0 += p1[r]; }
    const float rs = xhalf_sum(rs0);
    l += rowok ? rs : 0.f;
    const unsigned km = rowok ? 0xffffffffu : 0u;
    v4u pf[4];
    pf[0] = (v4u){cvtpk(p0[0], p0[1]) & km, cvtpk(p0[2], p0[3]) & km, cvtpk(p0[4], p0[5]) & km, cvtpk(p0[6], p0[7]) & km};
    pf[1] = (v4u){cvtpk(p0[8], p0[9]) & km, cvtpk(p0[10], p0[11]) & km, cvtpk(p0[12], p0[13]) & km, cvtpk(p0[14], p0[15]) & km};
    pf[2] = (v4u){cvtpk(p1[0], p1[1]) & km, cvtpk(p1[2], p1[3]) & km, cvtpk(p1[4], p1[5]) & km, cvtpk(p1[6], p1[7]) & km};
    pf[3] = (v4u){cvtpk(p1[8], p1[9]) & km, cvtpk(p1[10], p1[11]) & km, cvtpk(p1[12], p1[13]) & km, cvtpk(p1[14], p1[15]) & km};
    __builtin_amdgcn_s_setprio(1);
#pragma unroll
    for (int dh = 0; dh < 2; ++dh)
#pragma unroll
        for (int s = 0; s < 4; ++s) { const s16x4 lo = vtr(Vs + L.voff[dh][0] + 2048 * s), hi4 = vtr(Vs + L.voff[dh][1] + 2048 * s);
            const bf16x8 vf = (bf16x8){lo[0], lo[1], lo[2], lo[3], hi4[0], hi4[1], hi4[2], hi4[3]};
            o[dh] = __builtin_amdgcn_mfma_f32_32x32x16_bf16(vf, __builtin_bit_cast(bf16x8, pf[s]), o[dh], 0, 0, 0); }
    __builtin_amdgcn_s_setprio(0);
}
__device__ __forceinline__ void softmax2_pv(f32x16& a0, f32x16& a1, f32x16& b0, f32x16& b1, const LAS unsigned char* VsA, const LAS unsigned char* VsB, f32x16 (&o)[2], float& m, float& l, f32x16& cini,
                                            bool rowokA, bool rowokB, const LaneGeo& L) {
    float xa = max3f(a0[0], a0[1], a1[0]), xb = max3f(b0[0], b0[1], b1[0]);
#pragma unroll
    for (int r = 1; r < 15; r += 2) { xa = max3f(xa, a0[r + 1], a0[r + 2]); xa = max3f(xa, a1[r], a1[r + 1]); xb = max3f(xb, b0[r + 1], b0[r + 2]); xb = max3f(xb, b1[r], b1[r + 1]); }
    xa = __builtin_fmaxf(xa, a1[15]); xb = __builtin_fmaxf(xb, b1[15]);
    const float mxa = xhalf_max(xa), mxb = xhalf_max(xb);
    const float mx = __builtin_fmaxf(rowokA ? mxa : -INFINITY, rowokB ? mxb : -INFINITY);
    const bool grow = (mx > THR) || (l == 0.f && mx > MASK_TEST);
    if (__builtin_expect(__any(grow), 0)) {
        const float dl = grow ? mx : 0.f; m += dl; const float f = __builtin_amdgcn_exp2f(-dl); l *= f;
#pragma unroll
        for (int r = 0; r < 16; ++r) { a0[r] -= dl; a1[r] -= dl; b0[r] -= dl; b1[r] -= dl; o[0][r] *= f; o[1][r] *= f; cini[r] -= dl; }
    }
    float ra0 = 0.f, ra1 = 0.f, rb0 = 0.f, rb1 = 0.f;
#pragma unroll
    for (int r = 0; r < 16; ++r) { a0[r] = __builtin_amdgcn_exp2f(a0[r]); a1[r] = __builtin_amdgcn_exp2f(a1[r]); b0[r] = __builtin_amdgcn_exp2f(b0[r]); b1[r] = __builtin_amdgcn_exp2f(b1[r]);
        ra0 += a0[r]; ra0 += a1[r]; ra1 += b0[r]; ra1 += b1[r]; }
    const float rsa = xhalf_sum(ra0), rsb = xhalf_sum(ra1);
    l += (rowokA ? rsa : 0.f) + (rowokB ? rsb : 0.f);
    const unsigned ka = rowokA ? 0xffffffffu : 0u, kb = rowokB ? 0xffffffffu : 0u;
    v4u pa[4], pb[4];
    pa[0] = (v4u){cvtpk(a0[0], a0[1]) & ka, cvtpk(a0[2], a0[3]) & ka, cvtpk(a0[4], a0[5]) & ka, cvtpk(a0[6], a0[7]) & ka};
    pa[1] = (v4u){cvtpk(a0[8], a0[9]) & ka, cvtpk(a0[10], a0[11]) & ka, cvtpk(a0[12], a0[13]) & ka, cvtpk(a0[14], a0[15]) & ka};
    pa[2] = (v4u){cvtpk(a1[0], a1[1]) & ka, cvtpk(a1[2], a1[3]) & ka, cvtpk(a1[4], a1[5]) & ka, cvtpk(a1[6], a1[7]) & ka};
    pa[3] = (v4u){cvtpk(a1[8], a1[9]) & ka, cvtpk(a1[10], a1[11]) & ka, cvtpk(a1[12], a1[13]) & ka, cvtpk(a1[14], a1[15]) & ka};
    pb[0] = (v4u){cvtpk(b0[0], b0[1]) & kb, cvtpk(b0[2], b0[3]) & kb, cvtpk(b0[4], b0[5]) & kb, cvtpk(b0[6], b0[7]) & kb};
    pb[1] = (v4u){cvtpk(b0[8], b0[9]) & kb, cvtpk(b0[10], b0[11]) & kb, cvtpk(b0[12], b0[13]) & kb, cvtpk(b0[14], b0[15]) & kb};
    pb[2] = (v4u){cvtpk(b1[0], b1[1]) & kb, cvtpk(b1[2], b1[3]) & kb, cvtpk(b1[4], b1[5]) & kb, cvtpk(b1[6], b1[7]) & kb};
    pb[3] = (v4u){cvtpk(b1[8], b1[9]) & kb, cvtpk(b1[10], b1[11]) & kb, cvtpk(b1[12], b1[13]) & kb, cvtpk(b1[14], b1[15]) & kb};
    __builtin_amdgcn_s_setprio(1);
#pragma unroll
    for (int dh = 0; dh < 2; ++dh) {
#pragma unroll
        for (int s = 0; s < 4; ++s) { const s16x4 lo = vtr(VsA + L.voff[dh][0] + 2048 * s), hi4 = vtr(VsA + L.voff[dh][1] + 2048 * s);
            const bf16x8 vf = (bf16x8){lo[0], lo[1], lo[2], lo[3], hi4[0], hi4[1], hi4[2], hi4[3]};
            o[dh] = __builtin_amdgcn_mfma_f32_32x32x16_bf16(vf, __builtin_bit_cast(bf16x8, pa[s]), o[dh], 0, 0, 0); }
#pragma unroll
        for (int s = 0; s < 4; ++s) { const s16x4 lo = vtr(VsB + L.voff[dh][0] + 2048 * s), hi4 = vtr(VsB + L.voff[dh][1] + 2048 * s);
            const bf16x8 vf = (bf16x8){lo[0], lo[1], lo[2], lo[3], hi4[0], hi4[1], hi4[2], hi4[3]};
            o[dh] = __builtin_amdgcn_mfma_f32_32x32x16_bf16(vf, __builtin_bit_cast(bf16x8, pb[s]), o[dh], 0, 0, 0); } }
    __builtin_amdgcn_s_setprio(0);
}
__device__ __forceinline__ void store_o(bf16* orow, const f32x16 (&o)[2], int hi) {
#pragma unroll
    for (int dh = 0; dh < 2; ++dh)
#pragma unroll
        for (int a = 0; a < 4; ++a) { u32x2 w; w.x = cvtpk(o[dh][4 * a], o[dh][4 * a + 1]); w.y = cvtpk(o[dh][4 * a + 2], o[dh][4 * a + 3]);
            *(GAS u32x2*)(orow + 32 * dh + 8 * a + 4 * hi) = w; }
}
template <bool FIRST> __device__ __forceinline__ void out_branch(bf16* orow, const f32x16 (&o)[2], float sc, int hi) {
#pragma unroll
    for (int dh = 0; dh < 2; ++dh)
#pragma unroll
        for (int a = 0; a < 4; ++a) { GAS u32x2* p = (GAS u32x2*)(orow + 32 * dh + 8 * a + 4 * hi); float v0 = sc * o[dh][4 * a], v1 = sc * o[dh][4 * a + 1], v2 = sc * o[dh][4 * a + 2], v3 = sc * o[dh][4 * a + 3];
            if (!FIRST) { const u32x2 w = *p; v0 += __uint_as_float(w.x << 16); v1 += __uint_as_float(w.x & 0xffff0000u); v2 += __uint_as_float(w.y << 16); v3 += __uint_as_float(w.y & 0xffff0000u); }
            u32x2 w2; w2.x = cvtpk(v0, v1); w2.y = cvtpk(v2, v3); *p = w2; }
}
__device__ __forceinline__ void acc_branch(unsigned (&oacc)[2][8], const f32x16 (&o)[2], float sc) {
#pragma unroll
    for (int dh = 0; dh < 2; ++dh)
#pragma unroll
        for (int i = 0; i < 8; ++i) { const float lo = __uint_as_float(oacc[dh][i] << 16) + sc * o[dh][2 * i], hi2 = __uint_as_float(oacc[dh][i] & 0xffff0000u) + sc * o[dh][2 * i + 1]; oacc[dh][i] = cvtpk(lo, hi2); }
}
__device__ __forceinline__ void store_o_pk(bf16* orow, const unsigned (&oacc)[2][8], int hi) {
#pragma unroll
    for (int dh = 0; dh < 2; ++dh)
#pragma unroll
        for (int a = 0; a < 4; ++a) { u32x2 w; w.x = oacc[dh][2 * a]; w.y = oacc[dh][2 * a + 1]; *(GAS u32x2*)(orow + 32 * dh + 8 * a + 4 * hi) = w; }
}
__device__ __forceinline__ LAS v4u* oa_ptr(LAS unsigned char* lds, int wid, int lane, int k) { return (LAS v4u*)(lds + (k < 2 ? L_P4 : L_P3) + wid * 2048 + (k & 1) * 1024 + lane * 16); }
template <int MODE>
__device__ __forceinline__ void oa_branch(LAS unsigned char* lds, int wid, int lane, const f32x16 (&o)[2], float sc, bf16* orow, int hi) {
#pragma unroll
    for (int k = 0; k < 4; ++k) { const int dh = k >> 1, e0 = 8 * (k & 1); float v[8];
#pragma unroll
        for (int i = 0; i < 8; ++i) v[i] = sc * o[dh][e0 + i];
        if (MODE != 0) { const v4u w = *oa_ptr(lds, wid, lane, k);
#pragma unroll
            for (int i = 0; i < 4; ++i) { v[2 * i] += __uint_as_float(w[i] << 16); v[2 * i + 1] += __uint_as_float(w[i] & 0xffff0000u); } }
        v4u r; r.x = cvtpk(v[0], v[1]); r.y = cvtpk(v[2], v[3]); r.z = cvtpk(v[4], v[5]); r.w = cvtpk(v[6], v[7]);
        if (MODE != 2) *oa_ptr(lds, wid, lane, k) = r;
        else { *(GAS u32x2*)(orow + 32 * dh + 8 * (2 * (k & 1)) + 4 * hi) = (u32x2){r.x, r.y}; *(GAS u32x2*)(orow + 32 * dh + 8 * (2 * (k & 1) + 1) + 4 * hi) = (u32x2){r.z, r.w}; } }
}
__device__ __forceinline__ void build_tb(LAS unsigned short* tb, const float* rel_bias, int g, int wlim, int tid) {
    for (int i = tid; i < 4 * TSZ; i += 512) { const int h = i & 3, d = (i >> 2) - 64;
        unsigned short v = TB_MASK;
        if (d >= 0 && d < wlim) { const float x = (rel_bias[(int)BUCKET[d > 128 ? 128 : d] * NH + g * 4 + h] - rel_bias[31 * NH + g * 4 + h]) * LOG2E; v = (unsigned short)f2bf(x); }
        tb[i] = v; }
}
__device__ __forceinline__ void build_tb_global(unsigned short* tb, const float* rel_bias, int g, int wlim, int tid) {
    for (int i = tid; i < 4 * TSZ; i += 512) { const int h = i & 3, d = (i >> 2) - 64;
        unsigned short v = TB_MASK;
        if (d >= 0 && d < wlim) { const float x = (rel_bias[(int)BUCKET[d > 128 ? 128 : d] * NH + g * 4 + h] - rel_bias[31 * NH + g * 4 + h]) * LOG2E; v = (unsigned short)f2bf(x); }
        tb[i] = v; }
}
__device__ __forceinline__ void make_idf(bf16x8 (&idf)[2], int r32, int hi) {
    const int s_l = r32 >> 4, hh_l = (r32 >> 3) & 1, j_l = r32 & 7; const unsigned one = 0x3F80u << (16 * (j_l & 1));
#pragma unroll
    for (int s = 0; s < 2; ++s) { v4u w;
#pragma unroll
        for (int k = 0; k < 4; ++k) w[k] = (s == s_l && hi == hh_l && (j_l >> 1) == k) ? one : 0u;
        idf[s] = __builtin_bit_cast(bf16x8, w); }
}
__device__ __forceinline__ bf16x8 tb_frag(const LAS unsigned char* p) { const u32x2 a = *(const LAS u32x2*)p, b = *(const LAS u32x2*)(p + 8); return __builtin_bit_cast(bf16x8, (v4u){a.x, a.y, b.x, b.y}); }
__device__ __forceinline__ void bias_mma_u(f32x16& p0, f32x16& p1, const LAS unsigned char* tb, int D0, const LaneGeo& L, const bf16x8 (&idf)[2]) {
    const LAS unsigned char* bp = tb + (D0 + 8 * L.wid + 2 * L.hi - L.r32 + 32) * 8;
#pragma unroll
    for (int s = 0; s < 2; ++s) { const bf16x8 a1 = tb_frag(bp + 32 * s), a0 = tb_frag(bp + 256 + 32 * s);
        p0 = __builtin_amdgcn_mfma_f32_32x32x16_bf16(a0, idf[s], p0, 0, 0, 0); p1 = __builtin_amdgcn_mfma_f32_32x32x16_bf16(a1, idf[s], p1, 0, 0, 0); }
}
__device__ __forceinline__ void bias_mma_c(f32x16& p0, f32x16& p1, const LAS unsigned char* tb, int Dc, const LaneGeo& L, const bf16x8 (&idf)[2]) {
    const int db = Dc + 8 * L.wid + 2 * L.hi - 16 * L.r32;
#pragma unroll
    for (int s = 0; s < 2; ++s) { const int d0 = med3i(db + 4 * s, -2, 128), d1 = med3i(db + 4 * s - 512, -2, 128);
        const bf16x8 a0 = tb_frag(tb + (d0 + 64) * 8), a1 = tb_frag(tb + (d1 + 64) * 8);
        p0 = __builtin_amdgcn_mfma_f32_32x32x16_bf16(a0, idf[s], p0, 0, 0, 0); p1 = __builtin_amdgcn_mfma_f32_32x32x16_bf16(a1, idf[s], p1, 0, 0, 0); }
}

__device__ __forceinline__ float nsa_topk_val(const LAS float* P4, const LAS float* P3, int q, int j, int qb) {
    float v = P4[q * 64 + j] + (j > 0 ? P3[q * 64 + j - 1] : 0.f);
    const int code = (j == 0) ? 3 : (j == qb) ? 2 : (j == qb - 1) ? 1 : (j > qb) ? -(1024 + j) : 0;
    return code > 0 ? (float)code * 1e9f : (code < 0 ? (float)code * 1048576.0f : v);
}
__device__ __forceinline__ unsigned long long nsa_topk_exact(float v, int j) {
    int cnt = 0;
    for (int k = 0; k < 64; ++k) { const float vk = __int_as_float(__builtin_amdgcn_readlane(__float_as_int(v), k)); cnt += ((vk > v) || (vk == v && k < j)) ? 1 : 0; }
    return __ballot(cnt < 16);
}
__device__ __forceinline__ void nsa_topk(const LAS float* P4, const LAS float* P3, LAS unsigned long long* selm, int wid, int lane, int qb) {
    asm volatile("s_waitcnt lgkmcnt(0)" ::: "memory");
#pragma unroll 1
    for (int i = 0; i < 8; i += 2) { const int q = 8 * wid + i; const int j = lane;
        const float v0 = nsa_topk_val(P4, P3, q, j, qb), v1 = nsa_topk_val(P4, P3, q + 1, j, qb);
        float w0 = v0, w1 = v1; int c0 = 0, c1 = 0;
#pragma unroll
        for (int r = 1; r < 64; ++r) {
            w0 = __int_as_float(__builtin_amdgcn_mov_dpp(__float_as_int(w0), 0x13C, 0xF, 0xF, false));
            w1 = __int_as_float(__builtin_amdgcn_mov_dpp(__float_as_int(w1), 0x13C, 0xF, 0xF, false));
            c0 += (w0 > v0) ? 1 : 0; c1 += (w1 > v1) ? 1 : 0; }
        unsigned long long mk0 = __ballot(c0 < 16), mk1 = __ballot(c1 < 16);
        if (__builtin_popcountll(mk0) != 16) mk0 = nsa_topk_exact(v0, j);
        if (__builtin_popcountll(mk1) != 16) mk1 = nsa_topk_exact(v1, j);
        if (lane == 0) { selm[q] = mk0; selm[q + 1] = mk1; } }
    asm volatile("s_waitcnt lgkmcnt(0)" ::: "memory");
}

struct NsaArgs { const bf16* Q; const bf16* KV; const bf16* kcmp; const bf16* vcmp; const float* gates; const float* rel_bias; bf16* O; unsigned* work; const unsigned char* tbl; };
__device__ __forceinline__ void nsa_tile_src(const NsaArgs& A, int bg, int qb, int ntc, int nB, int j0, int ntot, int n, const bf16*& gK, const bf16*& gV) {
    const size_t base = (size_t)bg * SEQ * 64;
    if (n >= ntot) n = 0;
    if (n < ntc + nB) { const int ct = n < ntc ? n : n - ntc; gK = A.kcmp + (size_t)bg * 256 * 64 + (size_t)ct * 4096; gV = A.vcmp + (size_t)bg * 256 * 64 + (size_t)ct * 4096; return; }
    n -= ntc + nB;
    if (n <= qb) { gK = A.KV + 2 * KVT + base + (size_t)n * 4096; gV = A.KV + 3 * KVT + base + (size_t)n * 4096; return; }
    n -= qb + 1;
    gK = A.KV + 4 * KVT + base + (size_t)(j0 + n) * 4096; gV = A.KV + 5 * KVT + base + (size_t)(j0 + n) * 4096;
}
template <int VAR> __device__ __forceinline__ void nsa_unit(const NsaArgs& A, LAS unsigned char* lds, unsigned lds0, int b, int g, int qb, int tid) {
    asm volatile("" : "+v"(tid));
    LaneGeo L; L.init(tid);
    const int lane = L.lane, wid = L.wid, r32 = L.r32, hi = L.hi;
    const int ql = 8 * wid + (r32 >> 2), hj = r32 & 3, s0 = 64 * qb, tq = s0 + ql, bg = b * 4 + g;
    const LAS unsigned char* tb = lds + L_TB;
    LAS float* P4 = (LAS float*)(lds + L_P4); LAS float* P3 = (LAS float*)(lds + L_P3);
    LAS unsigned long long* selm = (LAS unsigned long long*)(lds + L_SEL);
    const int ncmp = 4 * qb + 3, ntc = (ncmp + 63) >> 6;
    const int nB = qb >= 16 ? ntc : 0;
    const int j0 = qb >= 8 ? qb - 8 : 0, nwin = qb - j0 + 1, ntot = ntc + nB + (qb + 1) + nwin;
    const bf16 *gK, *gV;
    if (wid < TSZ * 8 / 1024) glds16(A.tbl + g * (TSZ * 8) + wid * 1024 + lane * 16, (unsigned)__builtin_amdgcn_readfirstlane((int)(lds0 + L_TB + wid * 1024)));
#pragma unroll
    for (int n = 0; n < 4; ++n) { nsa_tile_src(A, bg, qb, ntc, nB, j0, ntot, n, gK, gV); dma_tile(L, gK, gV, lds0, n); }
    bf16x8 idf[2]; make_idf(idf, r32, hi);
    for (int i = lane; i < 512; i += 64) { P4[(8 * wid) * 64 + i] = 0.f; P3[(8 * wid) * 64 + i] = 0.f; }
    const size_t trow = (size_t)b * SEQ + tq;
    bf16x8 qr[4];
    { const bf16* qp = A.Q + trow * DM + g * 256 + hj * 64 + hi * 8;
#pragma unroll
      for (int d0 = 0; d0 < 4; ++d0) qr[d0] = *(const GAS bf16x8*)(qp + d0 * 16); }
    f32x16 o[2], p0, p1; float m = 0.f, l = 0.f, linv_c = 0.f;
    o[0] = (f32x16){}; o[1] = (f32x16){};
    unsigned mlo = qb >= 31 ? 0xffffffffu : ((2u << qb) - 1u), mhi = qb >= 32 ? (qb >= 63 ? 0xffffffffu : ((2u << (qb - 32)) - 1u)) : 0u;
    float bias_far = A.rel_bias[31 * NH + g * 4 + hj] * LOG2E; f32x16 cini;
    float gt0p, gt1p, gt2p; { const float* gp = A.gates + ((size_t)b * SEQ + tq) * 48 + g * 4 + hj; gt0p = gp[0] * DBG_S0; gt1p = gp[16] * DBG_S1; gt2p = gp[32] * DBG_S2; }
    asm volatile("" : "+v"(qr[0]), "+v"(qr[1]), "+v"(qr[2]), "+v"(qr[3]), "+v"(gt0p), "+v"(gt1p), "+v"(gt2p), "+v"(bias_far));
#pragma unroll
    for (int r = 0; r < 16; ++r) cini[r] = bias_far;
#define NSA_OROW (A.O + ((size_t)b * SEQ + tq) * DM + g * 256 + hj * 64)
#define NSA_GATE(br) (A.gates[((size_t)b * SEQ + tq) * 48 + (br) * 16 + g * 4 + hj])
    const int nsteps = (ntot + 1) >> 1;
    for (int st = 0; st < nsteps; ++st) {
        ATT_WAIT_BAR(4);
#pragma unroll
        for (int sub = 0; sub < 2; ++sub) { nsa_tile_src(A, bg, qb, ntc, nB, j0, ntot, 2 * st + 4 + sub, gK, gV); dma_tile(L, gK, gV, lds0, ((st + 2) % 3) * 2 + sub); }
        { const int eB_ = ntc + nB, jA = 2 * st - eB_;
          if (2 * st >= eB_ && jA + 1 <= qb - 3) {
              const bool rsA = ((jA < 32 ? (mlo >> jA) : (mhi >> (jA - 32))) & 1u) != 0u, rsB = ((jA + 1 < 32 ? (mlo >> (jA + 1)) : (mhi >> (jA + 1 - 32))) & 1u) != 0u;
              if (__any(rsA) && __any(rsB)) {
                  const LAS unsigned char* KsA = lds + L_RING + ((st % 3) * 2) * SLOT_B; const LAS unsigned char* KsB = KsA + SLOT_B;
                  f32x16 q0, q1;
                  qk_tile(p0, p1, KsA, qr, L, cini); qk_tile(q0, q1, KsB, qr, L, cini);
                  softmax2_pv(p0, p1, q0, q1, KsA + 8192, KsB + 8192, o, m, l, cini, rsA, rsB, L);
                  continue; } } }
#define NSA_ROWSEL(j_) ((((j_) < 32 ? (mlo >> (j_)) : (mhi >> ((j_) - 32))) & 1u) != 0u)
#define NSA_SCORES(P0, P1, nn, Ks_) do { const int n_ = (nn); qk_tile(P0, P1, Ks_, qr, L, cini); \
        if (n_ < ntc) { if ((s0 - 31 - 1024 * n_ - 16 * 63) < 128) bias_mma_c(P0, P1, tb, s0 - 31 - 1024 * n_, L, idf); } \
        else if (n_ < eS2_) { const int j_ = n_ - eB2_; if (j_ > qb - 3) bias_mma_u(P0, P1, tb, 64 * (qb - j_), L, idf); } \
        else { const int dj_ = qb - (j0 + (n_ - eS2_)); if (dj_ < 3 || dj_ > 7) bias_mma_u(P0, P1, tb, 64 * dj_, L, idf); } } while (0)
        { const int eB2_ = ntc + nB, eS2_ = eB2_ + qb + 1, n0 = 2 * st, n1 = n0 + 1;
          const bool inA = n1 < ntc, inS = n0 >= eB2_ && n1 < eS2_, inW = n0 >= eS2_ && n1 < ntot;
          if (inA || inS || inW) {
              bool rsA = true, rsB = true;
              if (inS) { rsA = NSA_ROWSEL(n0 - eB2_); rsB = NSA_ROWSEL(n1 - eB2_); }
              if (__any(rsA) && __any(rsB)) {
                  const LAS unsigned char* KsA = lds + L_RING + ((st % 3) * 2) * SLOT_B; const LAS unsigned char* KsB = KsA + SLOT_B;
                  f32x16 q0, q1;
                  NSA_SCORES(p0, p1, n0, KsA); NSA_SCORES(q0, q1, n1, KsB);
                  softmax2_pv(p0, p1, q0, q1, KsA + 8192, KsB + 8192, o, m, l, cini, rsA, rsB, L);
                  if (n1 == ntc - 1) { linv_c = l > 0.f ? 1.0f / l : 0.f; l = 0.f;
                      if (nB == 0) { oa_branch<0>(lds, wid, lane, o, gt0p * linv_c, nullptr, hi); m = 0.f;
#pragma unroll
                          for (int r = 0; r < 16; ++r) { o[0][r] = 0.f; o[1][r] = 0.f; cini[r] = bias_far; } } }
                  if (n1 == eS2_ - 1) { oa_branch<1>(lds, wid, lane, o, gt1p * (l > 0.f ? 1.0f / l : 0.f), nullptr, hi);
#pragma unroll
                      for (int r = 0; r < 16; ++r) { o[0][r] = 0.f; o[1][r] = 0.f; cini[r] = bias_far; }
                      m = 0.f; l = 0.f; }
                  continue; } } }
#undef NSA_SCORES
#undef NSA_ROWSEL
#pragma unroll 1
      for (int sub = 0; sub < 2; ++sub) {
        const int n = 2 * st + sub; if (n >= ntot) break;
        const LAS unsigned char* Ks = lds + L_RING + ((st % 3) * 2 + sub) * SLOT_B; const LAS unsigned char* Vs = Ks + 8192;
        if (n < ntc + nB) {
            const bool passB = n >= ntc; const int ct = passB ? n - ntc : n;
            const bool far = (s0 - 31 - 1024 * ct - 16 * 63) >= 128;
            qk_tile(p0, p1, Ks, qr, L, cini);
            if (!far) bias_mma_c(p0, p1, tb, s0 - 31 - 1024 * ct, L, idf);
            if (!passB) {
                softmax_pv(p0, p1, Vs, o, m, l, cini, true, L);
                if (n == ntc - 1) { linv_c = l > 0.f ? 1.0f / l : 0.f; l = 0.f;
                    if (nB == 0) { oa_branch<0>(lds, wid, lane, o, gt0p * linv_c, nullptr, hi); m = 0.f;
#pragma unroll
                        for (int r = 0; r < 16; ++r) { o[0][r] = 0.f; o[1][r] = 0.f; cini[r] = bias_far; } } }
            } else {
#pragma unroll
                for (int r = 0; r < 16; ++r) { p0[r] = __builtin_amdgcn_exp2f(p0[r]) * linv_c; p1[r] = __builtin_amdgcn_exp2f(p1[r]) * linv_c; }
#pragma unroll
                for (int pp = 0; pp < 2; ++pp)
#pragma unroll
                    for (int a = 0; a < 4; ++a) { float s3 = pp ? p1[4 * a + 3] : p0[4 * a + 3];
                        float s4 = pp ? (p1[4 * a] + p1[4 * a + 1]) + (p1[4 * a + 2] + p1[4 * a + 3]) : (p0[4 * a] + p0[4 * a + 1]) + (p0[4 * a + 2] + p0[4 * a + 3]);
                        s4 = quad_sum(s4); s3 = quad_sum(s3);
                        if (hj == 0) { const int j = 16 * ct + 8 * pp + 2 * a + hi; P4[ql * 64 + j] = s4; P3[ql * 64 + j] = s3; } }
                if (n == ntc + nB - 1) {
                    nsa_topk(P4, P3, selm, wid, lane, qb);
                    const unsigned long long mm = selm[ql]; mlo = (unsigned)mm; mhi = (unsigned)(mm >> 32);
                    oa_branch<0>(lds, wid, lane, o, gt0p * linv_c, nullptr, hi);
                    m = 0.f;
#pragma unroll
                    for (int r = 0; r < 16; ++r) { o[0][r] = 0.f; o[1][r] = 0.f; cini[r] = bias_far; }
                }
            }
        } else if (n < ntc + nB + qb + 1) {
            const int j = n - (ntc + nB);
            const bool rowsel = ((j < 32 ? (mlo >> j) : (mhi >> (j - 32))) & 1u) != 0u;
            if (__any(rowsel)) {
                qk_tile(p0, p1, Ks, qr, L, cini);
                if (j > qb - 3) bias_mma_u(p0, p1, tb, 64 * (qb - j), L, idf);
                softmax_pv(p0, p1, Vs, o, m, l, cini, rowsel, L);
            }
            if (j == qb) { oa_branch<1>(lds, wid, lane, o, gt1p * (l > 0.f ? 1.0f / l : 0.f), nullptr, hi);
#pragma unroll
                for (int r = 0; r < 16; ++r) { o[0][r] = 0.f; o[1][r] = 0.f; cini[r] = bias_far; }
                m = 0.f; l = 0.f; }
        } else {
            const int j = j0 + (n - (ntc + nB) - qb - 1); const int dj = qb - j;
            qk_tile(p0, p1, Ks, qr, L, cini);
            if (dj < 3 || dj > 7) bias_mma_u(p0, p1, tb, 64 * dj, L, idf);
            softmax_pv(p0, p1, Vs, o, m, l, cini, true, L);
        }
      }
    }
    oa_branch<2>(lds, wid, lane, o, gt2p * (l > 0.f ? 1.0f / l : 0.f), NSA_OROW, hi);
#undef NSA_OROW
#undef NSA_GATE
    ATT_WAIT_BAR(0);
}
template <int VAR> __device__ __forceinline__ void nsa_phase(const NsaArgs& A, LAS unsigned char* lds, unsigned lds0, int tid) {
    LAS int* nextu = (LAS int*)(lds + L_NEXT);
    int unext = 0;
    if (tid == 0) unext = (int)__hip_atomic_fetch_add(A.work, 1u, __ATOMIC_RELAXED, __HIP_MEMORY_SCOPE_AGENT);
    for (;;) {
        if (tid == 0) nextu[0] = unext;
        __syncthreads();
        const int u = nextu[0];
        __syncthreads();
        if (u >= NB * NG * 64) break;
        if (tid == 0) unext = (int)__hip_atomic_fetch_add(A.work, 1u, __ATOMIC_RELAXED, __HIP_MEMORY_SCOPE_AGENT);
        const int qb = 63 - (u >> 5), bg = u & 31;
        nsa_unit<VAR>(A, lds, lds0, bg >> 2, bg & 3, qb, tid);
    }
}

struct SwaArgs { const bf16* Q; const bf16* KV; const float* sinks; const float* rel_bias; bf16* O; };
constexpr int LS_QB = 4 * SLOT_B, LS_TAB = LS_QB + 2 * 32768, LS_END = LS_TAB + TSZ * 8;
static_assert(LS_END <= RING_BYTES, "SWA LDS");
__device__ __forceinline__ void swa_phase(const SwaArgs& A, LAS unsigned char* lds, unsigned lds0, int blk, int G, int tid) {
    LaneGeo L; L.init(tid);
    const int lane = L.lane, wid = L.wid, r32 = L.r32, hi = L.hi;
    const int hj = r32 & 3;
    const int nU = (NB * NG * 64 - blk + G - 1) / G, ntot = 3 * nU;
    const int g = (blk >> 6) & 3;
    const LAS unsigned char* tb = lds + LS_TAB;
    bf16x8 idf[2]; make_idf(idf, r32, hi);
#define SWA_TILE(tt, gK_, gV_, val_) do { int t_ = (tt); if (t_ >= ntot) t_ = ntot - 1; const int u_ = blk + G * (t_ / 3), qb_ = u_ & 63, bg_ = u_ >> 6; int j_ = qb_ - 2 + (t_ % 3); val_ = j_ >= 0; if (j_ < 0) j_ = 0; \
        gK_ = A.KV + (size_t)bg_ * SEQ * 64 + (size_t)j_ * 4096; gV_ = A.KV + KVT + (size_t)bg_ * SEQ * 64 + (size_t)j_ * 4096; } while (0)
#define SWA_QDMA(ii) do { int i_ = (ii); if (i_ >= nU) i_ = nU - 1; const int u_ = blk + G * i_, qb_ = u_ & 63, b_ = u_ >> 8; \
        _Pragma("unroll") for (int pc = 0; pc < 4; ++pc) { const int ql_ = 8 * wid + 2 * pc + (lane >> 5); \
            const char* src_ = (const char*)(A.Q + ((size_t)b_ * SEQ + 64 * qb_ + ql_) * DM + g * 256) + (lane & 31) * 16; \
            glds16(src_, (unsigned)__builtin_amdgcn_readfirstlane((int)(lds0 + LS_QB + ((ii) & 1) * 32768 + (4 * wid + pc) * 1024))); } } while (0)
    const bf16 *gK, *gV; bool val;
    SWA_QDMA(0);
#pragma unroll
    for (int t = 0; t < 3; ++t) { SWA_TILE(t, gK, gV, val); dma_tile(L, gK, gV, lds0, t); }
    build_tb((LAS unsigned short*)(lds + LS_TAB), A.rel_bias, g, 128, tid);
    const float sink = A.sinks[g * 4 + hj] * LOG2E;
    float sinkp = sink, bias_far = A.rel_bias[31 * NH + g * 4 + hj] * LOG2E; asm volatile("" : "+v"(sinkp), "+v"(bias_far));
    f32x16 cini = (f32x16){};
    bf16x8 qr[4]; f32x16 o[2], p0, p1; float m = 0.f, l = 1.f; int tq = 0;
    o[0] = (f32x16){}; o[1] = (f32x16){};
    for (int t = 0; t < ntot; ++t) {
        const int i = t / 3, k = t - 3 * i;
        if (k == 0) ATT_WAIT_BAR(4); else ATT_WAIT_BAR(8);
        { SWA_TILE(t + 3, gK, gV, val); dma_tile(L, gK, gV, lds0, (t + 3) & 3); }
        const int u = blk + G * i, qb = u & 63, b = u >> 8;
        if (k == 0) {
            SWA_QDMA(i + 1);
            const LAS unsigned char* qb_l = lds + LS_QB + (i & 1) * 32768 + (8 * wid + (r32 >> 2)) * 512 + hj * 128 + hi * 16;
#pragma unroll
            for (int d0 = 0; d0 < 4; ++d0) qr[d0] = *(const LAS bf16x8*)(qb_l + d0 * 32);
            m = sinkp; l = 1.0f; o[0] = (f32x16){}; o[1] = (f32x16){};
#pragma unroll
            for (int r = 0; r < 16; ++r) cini[r] = bias_far - m;
            tq = 64 * qb + 8 * wid + (r32 >> 2);
        }
        const int j = qb - 2 + k;
        if (j >= 0) {
            const LAS unsigned char* Ks = lds + L_RING + (t & 3) * SLOT_B; const LAS unsigned char* Vs = Ks + 8192;
            qk_tile(p0, p1, Ks, qr, L, cini);
            bias_mma_u(p0, p1, tb, 64 * (qb - j), L, idf);
            softmax_pv(p0, p1, Vs, o, m, l, cini, true, L);
        }
        if (k == 2) {
            const float sc = DBG_SWA / l;
#pragma unroll
            for (int r = 0; r < 16; ++r) { o[0][r] *= sc; o[1][r] *= sc; }
            store_o(A.O + ((size_t)b * SEQ + tq) * DM + g * 256 + hj * 64, o, hi);
        }
    }
#undef SWA_TILE
#undef SWA_QDMA
    ATT_WAIT_BAR(0);
}
}

using pg8::Unit; using pg8::f32x4;
struct SchedPlain {
    pg8::GridOrder go; int arow_off;
    __device__ bool next(int i, Unit& u) const { u.e = 0; u.lt = 0; return go.tile(i, u.pm, u.pn); }
    __device__ int a_row(const Unit& u, int r) const { return arow_off + u.pm * 256 + r; }
    __device__ int b_row0(const Unit& u) const { return u.pn * 256; }
};
struct SchedCmp {
    pg8::GridOrder go;
    __device__ bool next(int i, Unit& u) const { u.e = 0; u.lt = 0; return go.tile(i, u.pm, u.pn); }
    __device__ int a_row(const Unit& u, int r) const { return u.pm * 256 + r; }
    __device__ int b_row0(const Unit& u) const { return (u.pm >= 32 ? 512 : 0) + u.pn * 256; }
};
struct SchedCmpGate {
    int G, c, cmp_rowoff, cmp_brow;
    __device__ bool next(int i, Unit& u) const { const long L = (long)i * G + c; if (L >= 256) return false; u.lt = 0;
        if (L < 128) { u.e = 0; u.pm = (int)(L >> 1); u.pn = (int)(L & 1); } else { u.e = 1; u.pm = (int)L - 128; u.pn = 0; } return true; }
    __device__ int a_row(const Unit& u, int r) const { return (u.e ? 0 : cmp_rowoff) + u.pm * 256 + r; }
    __device__ int b_row0(const Unit& u) const { return u.e ? 2560 : cmp_brow + (u.pm >= 32 ? 512 : 0) + u.pn * 256; }
};
struct SchedL1 {
    pg8::GridOrder go; int xb_rowoff;
    __device__ bool next(int i, Unit& u) const { u.e = 0; u.lt = 0; return go.tile(i, u.pm, u.pn); }
    __device__ int a_row(const Unit& u, int r) const { return (u.pn >= 4 ? xb_rowoff : 0) + u.pm * 256 + r; }
    __device__ int b_row0(const Unit& u) const { return u.pn * 256; }
};
template <int NPN, bool GATHER, int BROWS>
struct SchedMoe {
    const unsigned* list; int G, c, ioff, imax; volatile LAS unsigned* tab;
    __device__ __forceinline__ void init(const unsigned* cnt, const unsigned* list_, int G_, int c_, volatile LAS unsigned* tab_, int ioff_ = 0, int imax_ = 1 << 28) { list = list_; G = G_; c = c_; tab = tab_; ioff = ioff_; imax = imax_;
        if (threadIdx.x == 0) { unsigned base = 0u; for (int e = 0; e < NE; ++e) { const unsigned n = cnt[e]; tab[e] = n; tab[16 + e] = base; base += (n + 255u) >> 8; } tab[32] = base; }
        __syncthreads(); }
    __device__ __forceinline__ bool next(int i, Unit& u) const {
        if (i >= imax) return false;
        const long L = (long)(i + ioff) * G + c; const int mt = (int)(L / NPN); u.pn = (int)(L % NPN); u.pm = mt; u.e = 0; u.lt = 0;
        if (mt >= (int)tab[32]) return false;
#pragma unroll
        for (int e = 0; e < NE; ++e) { const int pe = (int)tab[16 + e]; if (mt >= pe) { u.e = e; u.lt = mt - pe; } }
        u.e = __builtin_amdgcn_readfirstlane(u.e); u.lt = __builtin_amdgcn_readfirstlane(u.lt);
        return true;
    }
    __device__ __forceinline__ int a_row(const Unit& u, int r) const {
        if (!GATHER) return u.pm * 256 + r;
        const int idx = u.lt * 256 + r; return idx < (int)tab[u.e] ? (int)(list[(size_t)u.e * NT + idx] >> 1) : 0;
    }
    __device__ __forceinline__ int b_row0(const Unit& u) const { return u.e * BROWS + u.pn * 256; }
};

template <int NPN, int BROWS>
struct SchedMoeLate {
    const unsigned* flag; int G, c, R; volatile LAS unsigned* tab;
    __device__ __forceinline__ void init(const unsigned* cnt, int G_, int c_, volatile LAS unsigned* tab_, const unsigned* flag_) { G = G_; c = c_; tab = tab_; flag = flag_;
        if (threadIdx.x == 0) { unsigned base = 0u; for (int e = 0; e < NE; ++e) { const unsigned n = cnt[e]; tab[e] = n; tab[16 + e] = base; base += (n + 255u) >> 8; } tab[32] = base; }
        __syncthreads();
        const int r = 2 * (int)tab[32] - 2 * G; R = r < 0 ? 0 : (r > G ? G : r); }
    __device__ __forceinline__ bool next(int i, Unit& u) const {
        const int E = G - R;
        long L;
        if (c >= R) L = i < 2 ? (long)i * E + (c - R) : 2L * E + (long)(i - 2) * G + c; else L = 2L * E + (long)i * G + c;
        const int mt = (int)(L / NPN); u.pn = (int)(L % NPN); u.pm = mt; u.e = 0; u.lt = 0;
        if (mt >= (int)tab[32]) return false;
#pragma unroll
        for (int e = 0; e < NE; ++e) { const int pe = (int)tab[16 + e]; if (mt >= pe) { u.e = e; u.lt = mt - pe; } }
        u.e = __builtin_amdgcn_readfirstlane(u.e); u.lt = __builtin_amdgcn_readfirstlane(u.lt);
        if (mt >= G && R > 0) {
            unsigned sp = 0u;
            while (__hip_atomic_load(flag, __ATOMIC_RELAXED, __HIP_MEMORY_SCOPE_AGENT) < (unsigned)R) { __builtin_amdgcn_s_sleep(2); if (++sp > (1u << 22)) break; }
            __builtin_amdgcn_fence(__ATOMIC_ACQUIRE, "agent");
            asm volatile("s_waitcnt vmcnt(0)" ::: "memory"); }
        return true;
    }
    __device__ __forceinline__ int a_row(const Unit& u, int r) const { return u.pm * 256 + r; }
    __device__ __forceinline__ int b_row0(const Unit& u) const { return u.e * BROWS + u.pn * 256; }
};

__device__ __forceinline__ v4u pack8(const f32x4& a, const f32x4& b, float s) {
    v4u w; w.x = pg8::cvt_pk_bf16(a[0] * s, a[1] * s); w.y = pg8::cvt_pk_bf16(a[2] * s, a[3] * s); w.z = pg8::cvt_pk_bf16(b[0] * s, b[1] * s); w.w = pg8::cvt_pk_bf16(b[2] * s, b[3] * s); return w; }
__device__ __forceinline__ bf16* kv_addr(bf16* KV, int ten, int m, int c) { const int b = m >> 12, s = m & 4095, g = c >> 6, d = c & 63; return KV + (size_t)ten * KVT + ((size_t)((b * 4 + g) * SEQ + s)) * 64 + d; }

struct EpiProj {
    static constexpr bool PERM = true;
    bf16* Q; bf16* KV; float* gates;
    __device__ __forceinline__ void operator()(const f32x4 (&acc)[2][2][4][2], const Unit& u, int wr, int wc, int fr, int fq) const {
#pragma unroll
        for (int ai = 0; ai < 2; ++ai)
#pragma unroll
            for (int m = 0; m < 4; ++m) { const int row = u.pm * 256 + ai * 128 + wr * 64 + m * 16 + fr;
#pragma unroll
                for (int bj = 0; bj < 2; ++bj) { const int ct = bj * 128 + wc * 32 + 8 * fq; const f32x4 v0 = acc[ai][bj][m][0], v1 = acc[ai][bj][m][1];
                    if (u.pn < 4) { *(GAS v4u*)(Q + (size_t)row * DM + u.pn * 256 + ct) = pack8(v0, v1, QSCALE); }
                    else if (u.pn < 10) { *(GAS v4u*)kv_addr(KV, u.pn - 4, row, ct) = pack8(v0, v1, 1.0f); }
                    else if (ct < 48) { float* gp = gates + (size_t)row * 48 + ct;
                        *(GAS f32x4*)gp = (f32x4){sigmoidf_(v0[0]), sigmoidf_(v0[1]), sigmoidf_(v0[2]), sigmoidf_(v0[3])};
                        *(GAS f32x4*)(gp + 4) = (f32x4){sigmoidf_(v1[0]), sigmoidf_(v1[1]), sigmoidf_(v1[2]), sigmoidf_(v1[3])}; } } }
    }
};
struct EpiL1 {
    static constexpr bool PERM = true;
    bf16* Q; bf16* KV;
    __device__ __forceinline__ void operator()(const f32x4 (&acc)[2][2][4][2], const Unit& u, int wr, int wc, int fr, int fq) const {
#pragma unroll
        for (int ai = 0; ai < 2; ++ai)
#pragma unroll
            for (int m = 0; m < 4; ++m) { const int row = u.pm * 256 + ai * 128 + wr * 64 + m * 16 + fr;
#pragma unroll
                for (int bj = 0; bj < 2; ++bj) { const int ct = bj * 128 + wc * 32 + 8 * fq; const f32x4 v0 = acc[ai][bj][m][0], v1 = acc[ai][bj][m][1];
                    if (u.pn < 4) { *(GAS v4u*)(Q + (size_t)row * DM + u.pn * 256 + ct) = pack8(v0, v1, QSCALE); }
                    else { *(GAS v4u*)kv_addr(KV, u.pn - 4, row, ct) = pack8(v0, v1, 1.0f); } } }
    }
};
struct EpiF32 {
    static constexpr bool PERM = false;
    float* O; int ldc;
    __device__ __forceinline__ void operator()(const f32x4 (&acc)[2][2][4][2], const Unit& u, int wr, int wc, int fr, int fq) const {
#pragma unroll
        for (int ai = 0; ai < 2; ++ai)
#pragma unroll
            for (int m = 0; m < 4; ++m) { float* rp = O + (size_t)(u.pm * 256 + ai * 128 + wr * 64 + m * 16 + fr) * ldc + u.pn * 256 + wc * 32 + 4 * fq;
#pragma unroll
                for (int bj = 0; bj < 2; ++bj)
#pragma unroll
                    for (int n = 0; n < 2; ++n) *(GAS f32x4*)(rp + bj * 128 + n * 16) = acc[ai][bj][m][n]; }
    }
};
struct EpiCmpGate {
    static constexpr bool PERM = false;
    float* UL; float* gates;
    __device__ __forceinline__ void operator()(const f32x4 (&acc)[2][2][4][2], const Unit& u, int wr, int wc, int fr, int fq) const {
#pragma unroll
        for (int ai = 0; ai < 2; ++ai)
#pragma unroll
            for (int m = 0; m < 4; ++m) { const int row = u.pm * 256 + ai * 128 + wr * 64 + m * 16 + fr;
#pragma unroll
                for (int bj = 0; bj < 2; ++bj)
#pragma unroll
                    for (int n = 0; n < 2; ++n) { const int c = bj * 128 + wc * 32 + n * 16 + 4 * fq; const f32x4 v = acc[ai][bj][m][n];
                        if (u.e == 0) *(GAS f32x4*)(UL + (size_t)row * 512 + u.pn * 256 + c) = v;
                        else if (c < 48) *(GAS f32x4*)(gates + (size_t)row * 48 + c) = (f32x4){sigmoidf_(v[0]), sigmoidf_(v[1]), sigmoidf_(v[2]), sigmoidf_(v[3])}; } }
    }
};
struct EpiBf16 {
    static constexpr bool PERM = true;
    bf16* O; int ldc;
    __device__ __forceinline__ void operator()(const f32x4 (&acc)[2][2][4][2], const Unit& u, int wr, int wc, int fr, int fq) const {
#pragma unroll
        for (int ai = 0; ai < 2; ++ai)
#pragma unroll
            for (int m = 0; m < 4; ++m) { bf16* rp = O + (size_t)(u.pm * 256 + ai * 128 + wr * 64 + m * 16 + fr) * ldc + u.pn * 256 + wc * 32 + 8 * fq;
#pragma unroll
                for (int bj = 0; bj < 2; ++bj) *(GAS v4u*)(rp + bj * 128) = pack8(acc[ai][bj][m][0], acc[ai][bj][m][1], 1.0f); }
    }
};
struct EpiFp8 {
    static constexpr bool PERM = true;
    unsigned char* O; int ldc;
    __device__ __forceinline__ void operator()(const f32x4 (&acc)[2][2][4][2], const Unit& u, int wr, int wc, int fr, int fq) const {
#pragma unroll
        for (int ai = 0; ai < 2; ++ai)
#pragma unroll
            for (int m = 0; m < 4; ++m) { unsigned char* rp = O + (size_t)(u.pm * 256 + ai * 128 + wr * 64 + m * 16 + fr) * ldc + u.pn * 256 + wc * 32 + 8 * fq;
#pragma unroll
                for (int bj = 0; bj < 2; ++bj) { const f32x4 a = acc[ai][bj][m][0], b = acc[ai][bj][m][1]; int w0 = 0, w1 = 0;
                    w0 = __builtin_amdgcn_cvt_pk_fp8_f32(a[0], a[1], w0, false); w0 = __builtin_amdgcn_cvt_pk_fp8_f32(a[2], a[3], w0, true);
                    w1 = __builtin_amdgcn_cvt_pk_fp8_f32(b[0], b[1], w1, false); w1 = __builtin_amdgcn_cvt_pk_fp8_f32(b[2], b[3], w1, true);
                    *(GAS u32x2*)(rp + bj * 128) = (u32x2){(unsigned)w0, (unsigned)w1}; } }
    }
};
struct EpiGU {
    static constexpr bool PERM = true;
    bf16* he;
    __device__ __forceinline__ void operator()(const f32x4 (&acc)[2][2][4][2], const Unit& u, int wr, int wc, int fr, int fq) const {
#pragma unroll
        for (int ai = 0; ai < 2; ++ai)
#pragma unroll
            for (int m = 0; m < 4; ++m) { bf16* rp = he + (size_t)(u.pm * 256 + ai * 128 + wr * 64 + m * 16 + fr) * DE + u.pn * 128 + wc * 32 + 8 * fq;
                f32x4 h0, h1;
#pragma unroll
                for (int k = 0; k < 4; ++k) { h0[k] = siluf_(acc[ai][0][m][0][k]) * acc[ai][1][m][0][k]; h1[k] = siluf_(acc[ai][0][m][1][k]) * acc[ai][1][m][1][k]; }
                *(GAS v4u*)rp = pack8(h0, h1, 1.0f); }
    }
};
struct Args { const float* in[24]; float* out; unsigned char* ws; int ph_lo, ph_hi, li, pad; };
__global__ void __launch_bounds__(NWAVES * 64, 2) fwd(Args args) {
    extern __shared__ __attribute__((aligned(16))) unsigned char lds_raw[];
    LAS unsigned char* lds = (LAS unsigned char*)lds_raw;
    const int tid = threadIdx.x, lane = tid & 63, wave = __builtin_amdgcn_readfirstlane(tid >> 6);
    const int G = gridDim.x, blk = blockIdx.x;
    const int gw = blk * NWAVES + wave, ngw = G * NWAVES;
    unsigned char* ws = args.ws;
    gu32* ctl = (gu32*)(ws + WS_CTL);
    volatile LAS unsigned* MISC = (volatile LAS unsigned*)(lds + MISC_OFF);
    if (tid < 64) MISC[tid] = 0u;
    __syncthreads();
    XcdBarrier bar; bar.bar = (unsigned*)ctl + CW_BAR + args.li * XCD_BAR_WORDS; bar.x = 0; bar.st = nullptr;
    if (MK_N_LAUNCHES == 1) bar = xcd_barrier_post((unsigned*)ctl + CW_BAR + args.li * XCD_BAR_WORDS, MISC + 8);
    const int lo = args.ph_lo, hi = args.ph_hi;
#ifndef PHASE_MASK
#define PHASE_MASK 0x3ffff
#endif
#define IN(k) (((PHASE_MASK >> (k)) & 1) && lo <= (k) && (k) < hi)
#ifndef DBG_REP_MASK
#define DBG_REP_MASK 0
#endif
#define NREP(k) (1 + ((DBG_REP_MASK >> (k)) & 1) * 2)
#ifndef DBG_TIME_OFF
#define DBG_TIME_OFF 10.0f
#endif
#ifdef DBG_TIME_PHASE
    unsigned long long* tsv = (unsigned long long*)(ws + WS_CTL + 80000);
#define TS(k) do { if (blk == 0 && tid == 0) tsv[k] = __builtin_amdgcn_s_memrealtime(); } while (0)
#else
#define TS(k) do {} while (0)
#endif
#define SEAM(k) do { if (IN(k) && IN((k) + 1)) xcd_barrier(bar); TS((k) + 1); } while (0)
#define x (args.in[0])
#define c_in (args.in[1])
#define nsa_w_in (args.in[2])
#define cmp_k_w1 (args.in[3])
#define cmp_k_w2 (args.in[4])
#define cmp_v_w1 (args.in[5])
#define cmp_v_w2 (args.in[6])
#define cmp_k_pos (args.in[7])
#define cmp_v_pos (args.in[8])
#define nsa_w_out (args.in[9])
#define swa_w_q (args.in[10])
#define swa_sinks (args.in[11])
#define swa_w_out (args.in[12])
#define shared_w_kv (args.in[13])
#define rel_bias (args.in[14])
#define router_w (args.in[15])
#define router_b (args.in[16])
#define moe_w_gate (args.in[17])
#define moe_w_up (args.in[18])
#define moe_w_down (args.in[19])
#define ada_w (args.in[20])
#define ada_b (args.in[21])
#define ln_g (args.in[22])
#define ln_b (args.in[23])
#define out (args.out)
#define bufA ((bf16*)(ws + WS_A))
#define bufB ((bf16*)(ws + WS_B))
#define bufC ((bf16*)(ws + WS_C))
#define bufD ((bf16*)(ws + WS_D))
#define bufE ((bf16*)(ws + WS_E))
#define cnt0 ((unsigned*)ctl + CW_CNT0)
#define cnt1 ((unsigned*)ctl + CW_CNT1)
#define list ((const unsigned*)(ws + WS_LIST))
#define tokw ((const float*)(ws + WS_TOKW))

    TS(0);
    if (IN(0)) {
        P0Args a{c_in, nsa_w_in, cmp_k_w1, cmp_v_w1, cmp_k_pos, cmp_v_pos, nsa_w_out, swa_w_q, shared_w_kv, swa_w_out, moe_w_gate, moe_w_up, moe_w_down, ada_w, ada_b, ws};
        p0_small(a, lds, blk, G, tid);
        p0_transposes(a, lds, gw, ngw, wave, lane);
        if (blk >= G - 4) att::build_tb_global((unsigned short*)(ws + WS_TBL) + (blk - (G - 4)) * (4 * att::TSZ), rel_bias, blk - (G - 4), 512, tid);
    }
    SEAM(0);
    if (IN(1)) for (int rep = 0; rep < NREP(1); ++rep) p_modulate(x, ws, 0, bufA, gw, ngw, lane);
    SEAM(1);
    if (IN(2)) for (int rep = 0; rep < NREP(2); ++rep) {
        pg8::Gemm g{bufA, (const bf16*)(ws + WS_WIN), DM, DM}; SchedPlain S; S.go.init(NT / 256, 10, G, blk); S.arow_off = 0;
        EpiProj E{bufB, bufC, (float*)(ws + WS_GATE)};
        pg8::gemm_phase(lds + RING_OFF, g, S, E);
    }
    SEAM(2);
    if (IN(3)) for (int rep = 0; rep < NREP(3); ++rep) {
        pg8::Gemm g{bufA, (const bf16*)(ws + WS_WIN), DM, DM}; SchedCmpGate S{G, blk, (int)((WS_C - WS_A) / (DM * 2)), (int)((WS_CW1 - WS_WIN) / (DM * 2))};
        EpiCmpGate E{(float*)(ws + WS_UL), (float*)(ws + WS_GATE)};
        pg8::gemm_phase(lds + RING_OFF, g, S, E);
    }
    SEAM(3);
    if (IN(4)) for (int rep = 0; rep < NREP(4); ++rep) p_cmp_tail(cmp_k_w2, cmp_v_w2, ws, lds, blk, G, tid);
    SEAM(4);
    if (IN(5)) {
        { att::NsaArgs A{bufB, bufC, (const bf16*)(ws + WS_KCMP), (const bf16*)(ws + WS_VCMP), (const float*)(ws + WS_GATE), rel_bias, bufA, (unsigned*)ctl + 64 + 64 * args.li, ws + WS_TBL};
          att::nsa_phase<0>(A, lds, (unsigned)(uintptr_t)lds_raw, tid); }
    }
    SEAM(5);
    if (IN(6)) for (int rep = 0; rep < NREP(6); ++rep) {
        pg8::Gemm g{bufA, (const bf16*)(ws + WS_WOUT0), DM, DM}; SchedPlain S; S.go.init(NT / 256, 4, G, blk); S.arow_off = 0;
        EpiBf16 E{bufB, DM};
        pg8::gemm_phase(lds + RING_OFF, g, S, E);
    }
    SEAM(6);
    if (IN(7)) { LnRouterArgs a{x, nullptr, bufB, bufE, bufA, ln_g, ln_b, router_w, router_b, ws, 0, cnt0}; p_ln_router<false>(a, lds, blk, G, tid); }
    SEAM(7);
    if (IN(8)) for (int rep = 0; rep < NREP(8); ++rep) {
        pg8::Gemm g{bufA, (const bf16*)(ws + WS_WGU), DM, DM}; SchedMoe<2, true, 512> S; S.init(cnt0, list, G, blk, MISC + 16, 0, 2);
        EpiGU E{bufD};
        pg8::gemm_phase(lds + RING_OFF, g, S, E);
    }
    SEAM(8);
    if (IN(9)) for (int rep = 0; rep < NREP(9); ++rep) {
        { pg8::Gemm g{bufA, (const bf16*)(ws + WS_WGU), DM, DM}; SchedMoe<2, true, 512> S; S.init(cnt0, list, G, blk, MISC + 16, 2);
          EpiGU E{bufD};
          const bool producer = 2 * G + blk < 2 * (int)MISC[16 + 32];
          pg8::gemm_phase(lds + RING_OFF, g, S, E);
          if (producer && tid == 0) { __builtin_amdgcn_fence(__ATOMIC_RELEASE, "agent"); asm volatile("s_waitcnt vmcnt(0)" ::: "memory");
              (void)__hip_atomic_fetch_add((unsigned*)ctl + CW_DEP0, 1u, __ATOMIC_RELAXED, __HIP_MEMORY_SCOPE_AGENT); } }
        pg8::Gemm g{bufD, (const bf16*)(ws + WS_WD), DE, DE}; SchedMoeLate<4, 1024> S; S.init(cnt0, G, blk, MISC + 16, (const unsigned*)ctl + CW_DEP0);
        EpiFp8 E{(unsigned char*)bufC, DM};
        pg8::gemm_phase(lds + RING_OFF, g, S, E);
    }
    SEAM(9);
    if (IN(10)) p_ln_ffn<false>(nullptr, bufE, nullptr, bufB, (const unsigned char*)bufC, ln_g, ln_b, ln_g + DM, ln_b + DM, ws, 0, bufD, bufA, cnt0, lds, gw, ngw, tid);
    SEAM(10);
    if (IN(11)) for (int rep = 0; rep < NREP(11); ++rep) {
        pg8::Gemm g{bufA, (const bf16*)(ws + WS_WQ1), DM, DM}; SchedL1 S; S.go.init(NT / 256, 6, G, blk); S.xb_rowoff = (int)((WS_D - WS_A) / (DM * 2));
        EpiL1 E{bufB, bufC};
        pg8::gemm_phase(lds + RING_OFF, g, S, E);
    }
    SEAM(11);
    if (IN(12)) for (int rep = 0; rep < NREP(12); ++rep) {
        att::SwaArgs A{bufB, bufC, swa_sinks, rel_bias, bufA};
        att::swa_phase(A, lds, (unsigned)(uintptr_t)lds_raw, blk, G, tid);
    }
    SEAM(12);
    if (IN(13)) {
        pg8::Gemm g{bufA, (const bf16*)(ws + WS_WOUT1), DM, DM}; SchedPlain S; S.go.init(NT / 256, 4, G, blk); S.arow_off = 0;
        EpiBf16 E{bufB, DM};
        pg8::gemm_phase(lds + RING_OFF, g, S, E);
    }
    SEAM(13);
    if (IN(14)) { LnRouterArgs a{nullptr, bufD, bufB, bufD, bufA, ln_g + 2 * DM, ln_b + 2 * DM, router_w, router_b, ws, 1, cnt1}; p_ln_router<true>(a, lds, blk, G, tid); }
    SEAM(14);
    if (IN(15)) {
        pg8::Gemm g{bufA, (const bf16*)(ws + WS_WGU) + (size_t)NE * 512 * DM, DM, DM}; SchedMoe<2, true, 512> S; S.init(cnt1, list, G, blk, MISC + 16, 0, 2);
        EpiGU E{bufE};
        pg8::gemm_phase(lds + RING_OFF, g, S, E);
    }
    SEAM(15);
    if (IN(16)) {
        { pg8::Gemm g{bufA, (const bf16*)(ws + WS_WGU) + (size_t)NE * 512 * DM, DM, DM}; SchedMoe<2, true, 512> S; S.init(cnt1, list, G, blk, MISC + 16, 2);
          EpiGU E{bufE};
          const bool producer = 2 * G + blk < 2 * (int)MISC[16 + 32];
          pg8::gemm_phase(lds + RING_OFF, g, S, E);
          if (producer && tid == 0) { __builtin_amdgcn_fence(__ATOMIC_RELEASE, "agent"); asm volatile("s_waitcnt vmcnt(0)" ::: "memory");
              (void)__hip_atomic_fetch_add((unsigned*)ctl + CW_DEP1, 1u, __ATOMIC_RELAXED, __HIP_MEMORY_SCOPE_AGENT); } }
        pg8::Gemm g{bufE, (const bf16*)(ws + WS_WD) + (size_t)NE * DM * DE, DE, DE}; SchedMoeLate<4, 1024> S; S.init(cnt1, G, blk, MISC + 16, (const unsigned*)ctl + CW_DEP1);
        EpiFp8 E{(unsigned char*)bufC, DM};
        pg8::gemm_phase(lds + RING_OFF, g, S, E);
    }
    SEAM(16);
    if (IN(17)) p_ln_ffn<true>(nullptr, bufD, out, bufB, (const unsigned char*)bufC, ln_g + 2 * DM, ln_b + 2 * DM, ln_g + 3 * DM, ln_b + 3 * DM, ws, 1, nullptr, nullptr, cnt1, lds, gw, ngw, tid);
#undef IN
#undef SEAM
#undef x
#undef c_in
#undef out
#undef list
#undef tokw
#undef bufA
#undef bufB
#undef bufC
#undef bufD
#undef bufE
#undef cnt0
#undef cnt1
#undef ln_g
#undef ln_b
#undef rel_bias
#undef router_w
#undef router_b
}

#ifdef DBG_NSA_VAR
__global__ void __launch_bounds__(NWAVES * 64, 2) nsa_probe(Args args) {
    extern __shared__ __attribute__((aligned(16))) unsigned char lds_raw[];
    LAS unsigned char* lds = (LAS unsigned char*)lds_raw;
    unsigned char* ws = args.ws; gu32* ctl = (gu32*)(ws + WS_CTL);
    att::NsaArgs A{(const bf16*)(ws + WS_B), (const bf16*)(ws + WS_C), (const bf16*)(ws + WS_KCMP), (const bf16*)(ws + WS_VCMP), (const float*)(ws + WS_GATE), args.in[14], (bf16*)(ws + WS_D), (unsigned*)ctl + 128, ws + WS_TBL};
    att::nsa_phase<DBG_NSA_VAR>(A, lds, (unsigned)(uintptr_t)lds_raw, (int)threadIdx.x);
}
#endif
extern "C" void kernel_launch(void* const* d_in, const int* in_sizes, int n_in, void* d_out, int out_size, void* d_ws, size_t ws_size, hipStream_t stream) {
    static int grid = 0;
    if (grid == 0) {
        if (n_in != 24 || in_sizes[0] != NT * DM || out_size != NT * DM || ws_size < WS_END) { fprintf(stderr, "kernel_launch: unexpected shapes (n_in %d, in0 %d, out %d, ws %zu); nothing launched\n", n_in, n_in > 0 ? in_sizes[0] : -1, out_size, ws_size); grid = -1; return; }
        int dev = 0, cus = 0, per_cu = 0;
        if (hipGetDevice(&dev) != hipSuccess || hipDeviceGetAttribute(&cus, hipDeviceAttributeMultiprocessorCount, dev) != hipSuccess) { grid = -1; return; }
        if (hipFuncSetAttribute((const void*)fwd, hipFuncAttributeMaxDynamicSharedMemorySize, LDS_BYTES) != hipSuccess) { fprintf(stderr, "kernel_launch: hipFuncSetAttribute failed\n"); grid = -1; return; }
        if (hipOccupancyMaxActiveBlocksPerMultiprocessor(&per_cu, (const void*)fwd, NWAVES * 64, LDS_BYTES) != hipSuccess || per_cu < 1) fprintf(stderr, "kernel_launch: occupancy query reports %d\n", per_cu);
        (void)hipGetLastError();
        grid = cus;
        if (grid != 256) { fprintf(stderr, "kernel_launch: built for a 256-CU device, found %d CUs; nothing launched\n", cus); grid = -1; return; }
    }
    if (grid < 0) return;
    if (hipMemsetAsync((char*)d_ws + WS_CTL, 0, CTL_ZERO_BYTES, stream) != hipSuccess) return;
    Args a{};
    for (int i = 0; i < 24; ++i) a.in[i] = (const float*)d_in[i];
    a.out = (float*)d_out; a.ws = (unsigned char*)d_ws;
#if defined(DBG_REDO_PHASE)
    a.ph_lo = 0; a.ph_hi = DBG_REDO_PHASE + 1; a.li = 0; hipLaunchKernelGGL(fwd, dim3(grid), dim3(NWAVES * 64), LDS_BYTES, stream, a);
    a.ph_lo = DBG_REDO_PHASE; a.ph_hi = DBG_REDO_PHASE + 1; a.li = 1; hipLaunchKernelGGL(fwd, dim3(grid), dim3(NWAVES * 64), LDS_BYTES, stream, a);
    a.ph_lo = DBG_REDO_PHASE + 1; a.ph_hi = N_PHASES; a.li = 2; hipLaunchKernelGGL(fwd, dim3(grid), dim3(NWAVES * 64), LDS_BYTES, stream, a);
#elif defined(DBG_NSA_VAR)
    (void)hipFuncSetAttribute((const void*)nsa_probe, hipFuncAttributeMaxDynamicSharedMemorySize, LDS_BYTES);
    a.ph_lo = 0; a.ph_hi = 6; a.li = 0; hipLaunchKernelGGL(fwd, dim3(grid), dim3(NWAVES * 64), LDS_BYTES, stream, a);
    hipLaunchKernelGGL(nsa_probe, dim3(grid), dim3(NWAVES * 64), LDS_BYTES, stream, a);
    a.ph_lo = 6; a.ph_hi = N_PHASES; a.li = 1; hipLaunchKernelGGL(fwd, dim3(grid), dim3(NWAVES * 64), LDS_BYTES, stream, a);
#elif MK_N_LAUNCHES == 1
    a.ph_lo = 0; a.ph_hi = N_PHASES;
    hipLaunchKernelGGL(fwd, dim3(grid), dim3(NWAVES * 64), LDS_BYTES, stream, a);
#else
    for (int p = 0; p < N_PHASES; ++p) { a.ph_lo = p; a.ph_hi = p + 1; hipLaunchKernelGGL(fwd, dim3(grid), dim3(NWAVES * 64), LDS_BYTES, stream, a); }
#endif
}
```

```cpp
#include <hip/hip_runtime.h>
#include <cstdio>
#include <cstdint>

#ifndef MK_N_LAUNCHES
#define MK_N_LAUNCHES 1
#endif
constexpr int N_PHASES = 18;
#ifndef DBG_SCALES
#define DBG_SCALES 1.0f, 1.0f, 1.0f, 1.0f
#endif
constexpr float DBG_ARR[4] = {DBG_SCALES};
constexpr float DBG_S0 = DBG_ARR[0], DBG_S1 = DBG_ARR[1], DBG_S2 = DBG_ARR[2], DBG_SWA = DBG_ARR[3];

constexpr int NB = 8, SEQ = 4096, DM = 1024, NT = NB * SEQ;
constexpr int NH = 16, NG = 4, NJ = 4, HD = 64;
constexpr int NSA_IN = 2608, NPROJ = 2816;
constexpr int NE = 16, DE = 256;
constexpr float ALPHA_F = 1.4142135623730951f;
constexpr float LN_EPS_F = 1e-5f;
constexpr float LOG2E = 1.4426950408889634f;
constexpr float QSCALE = 0.125f * LOG2E;
constexpr float NEG_BIG = -1e30f;

constexpr size_t MiB = 1u << 20;
constexpr size_t WS_CTL = 0, CTL_ZERO_BYTES = 1 * MiB;
constexpr size_t WS_ADA = 1 * MiB;
constexpr size_t WS_POSB = WS_ADA + 2 * 8 * 6144 * 4;
constexpr size_t WS_TBL = WS_ADA + 512 * 1024;
constexpr size_t WS_WIN = 2 * MiB;
constexpr size_t WS_CW1 = 8 * MiB;
constexpr size_t WS_WOUT0 = 10 * MiB, WS_WQ1 = 12 * MiB, WS_WKV = 14 * MiB, WS_WOUT1 = 15 * MiB;
constexpr size_t WS_WGU = 18 * MiB;
constexpr size_t WS_WD = 50 * MiB;
constexpr size_t WS_LIST = 66 * MiB;
constexpr size_t WS_TOKW = 68 * MiB;
constexpr size_t WS_TOKPOS = WS_TOKW + 512 * 1024;
constexpr size_t WS_KCMP = 69 * MiB, WS_VCMP = 70 * MiB;
constexpr size_t WS_GATE = 71 * MiB;
constexpr size_t WS_A = 80 * MiB;
constexpr size_t WS_B = 144 * MiB;
constexpr size_t WS_C = 208 * MiB;
constexpr size_t WS_UL = WS_C + 100 * MiB;
constexpr size_t WS_D = 344 * MiB;
constexpr size_t WS_E = 408 * MiB;
constexpr size_t WS_END = 472 * MiB;
constexpr size_t KVT = (size_t)NB * NG * SEQ * HD;
constexpr int CW_BAR = 4096;
constexpr int CW_CNT0 = 16384, CW_CNT1 = 16384 + 64;
constexpr int CW_DEP0 = 16384 + 128, CW_DEP1 = 16384 + 192;

namespace pg8 {
#define PG8_LAS __attribute__((address_space(3)))
typedef unsigned short bf16_t;
typedef short bf16x8 __attribute__((ext_vector_type(8)));
typedef float f32x4 __attribute__((ext_vector_type(4)));
typedef unsigned u32x4 __attribute__((ext_vector_type(4)));
constexpr int BM = 256, BK = 64, HALF = 128, HTB = HALF * BK * 2  , STAGE_BYTES = 8 * HTB, NXCD = 8, WGM = 8;

__host__ __device__ __forceinline__ int lds_byte(int r, int c) { const int st = (r >> 4) * 2 + (c >> 5), rr = r & 15, cc = c & 31, ob = rr * 64 + cc * 2; return st * 1024 + (ob ^ (((ob >> 9) & 1) << 5)); }
__host__ __device__ __forceinline__ void stage_rc(int b, int& R, int& C) { const int st = b / 1024, sb = b % 1024, swz = sb ^ (((sb >> 9) & 1) << 5); R = (st >> 1) * 16 + swz / 64; C = (st & 1) * 32 + (swz % 64) / 2; }
__host__ __device__ __forceinline__ int perm32(int rho) { const int n = rho >> 4, i = rho & 15; return 8 * (i >> 2) + 4 * n + (i & 3); }

struct Unit { int pm, pn, e, lt; };
struct Gemm { const bf16_t* A; const bf16_t* Bt; int lda; int K; };

struct GridOrder {
    int nM, nN, nwg, G, c;
    __device__ void init(int nM_, int nN_, int G_, int c_) { nM = nM_; nN = nN_; nwg = nM * nN; G = G_; c = c_; }
    __device__ bool tile(int i, int& pm, int& pn) const {
        const long L = (long)i * G + c; if (L >= nwg) return false;
        int wgid = (int)L; { const int q = nwg / NXCD, r = nwg % NXCD, xcd = wgid % NXCD, off = wgid / NXCD; wgid = (xcd < r ? xcd * (q + 1) : r * (q + 1) + (xcd - r) * q) + off; }
        const int nig = WGM * nN, gid = wgid / nig, fm = gid * WGM, gsz = (nM - fm) < WGM ? (nM - fm) : WGM;
        pm = fm + ((wgid % nig) % gsz); pn = (wgid % nig) / gsz; return true;
    }
};

__device__ __forceinline__ unsigned cvt_pk_bf16(float lo, float hi) { unsigned r; asm volatile("v_cvt_pk_bf16_f32 %0, %1, %2" : "=v"(r) : "v"(lo), "v"(hi)); return r; }

template <class Epi, class Sched>
__device__ __forceinline__ void gemm_phase(PG8_LAS unsigned char* lds, const Gemm g, const Sched& S, const Epi& E) {
    const int tid = threadIdx.x, wid = __builtin_amdgcn_readfirstlane(tid >> 6), lane = tid & 63, wr = wid >> 2, wc = wid & 3, fr = lane & 15, fq = lane >> 4;
    int K = g.K; asm volatile("" : "+s"(K));
    const int nt = K / BK;
    int RA[2], CA[2]; unsigned voffB[2];
#pragma unroll
    for (int i = 0; i < 2; ++i) { int R, C; stage_rc(tid * 16 + i * 8192, R, C); const int Rb = Epi::PERM ? ((R & ~31) + perm32(R & 31)) : R;
        RA[i] = R; CA[i] = C; voffB[i] = (unsigned)(Rb * K + C) * 2u; }
    const size_t kstep = (size_t)(BK * 2);
    const size_t hstep = (size_t)HALF * K * 2;
    const unsigned ldsw = (unsigned)wid * 1024u;
    const int aoff = lds_byte(wr * 64 + fr, fq * 8), boff = lds_byte(wc * 32 + fr, fq * 8);
#define PG8_SA(b, h) (((b) * 2 + (h)) * HTB)
#define PG8_SB(b, h) ((4 + (b) * 2 + (h)) * HTB)
#define PG8_STAGE(bufoff, gbase, voff) do { _Pragma("unroll") for (int _i = 0; _i < 2; ++_i) \
        __builtin_amdgcn_global_load_lds((const unsigned*)((const char*)(gbase) + (voff)[_i]), (PG8_LAS unsigned*)(lds + (bufoff) + ldsw + _i * 8192), 16, 0, 0); } while (0)
#define PG8_AOFFS(ao, u) do { _Pragma("unroll") for (int _h = 0; _h < 2; ++_h) _Pragma("unroll") for (int _i = 0; _i < 2; ++_i) \
        (ao)[_h][_i] = (unsigned)(S.a_row((u), _h * HALF + RA[_i]) * g.lda + CA[_i]) * 2u; } while (0)
#define PG8_LDA(dst, b, h) do { _Pragma("unroll") for (int m = 0; m < 4; ++m) _Pragma("unroll") for (int k = 0; k < 2; ++k) dst[m][k] = *(const PG8_LAS bf16x8*)(lds + PG8_SA(b, h) + aoff + m * 2048 + k * 1024); } while (0)
#define PG8_LDB(dst, b, h) do { _Pragma("unroll") for (int n = 0; n < 2; ++n) _Pragma("unroll") for (int k = 0; k < 2; ++k) dst[n][k] = *(const PG8_LAS bf16x8*)(lds + PG8_SB(b, h) + boff + n * 2048 + k * 1024); } while (0)
#define PG8_MMA(ai, bj, At, Bt) do { __builtin_amdgcn_s_setprio(1); _Pragma("unroll") for (int m = 0; m < 4; ++m) _Pragma("unroll") for (int n = 0; n < 2; ++n) _Pragma("unroll") for (int k = 0; k < 2; ++k) \
        acc[ai][bj][m][n] = __builtin_amdgcn_mfma_f32_16x16x32_bf16(Bt[n][k], At[m][k], acc[ai][bj][m][n], 0, 0, 0); __builtin_amdgcn_s_setprio(0); } while (0)
#define PG8_WAIT_V(n) asm volatile("s_waitcnt vmcnt(" #n ")" ::: "memory")
#define PG8_WAIT_L(n) asm volatile("s_waitcnt lgkmcnt(" #n ")" ::: "memory")
#define PG8_BAR __builtin_amdgcn_s_barrier()
#define PG8_SCHED __builtin_amdgcn_sched_barrier(0)
    Unit cur, nxt; int ui = 0;
    if (!S.next(0, cur)) return;
    f32x4 acc[2][2][4][2];
#pragma unroll
    for (int a = 0; a < 2; ++a)
#pragma unroll
        for (int b = 0; b < 2; ++b)
#pragma unroll
            for (int m = 0; m < 4; ++m)
#pragma unroll
                for (int n = 0; n < 2; ++n) acc[a][b][m][n] = (f32x4){0.f, 0.f, 0.f, 0.f};
    bf16x8 At[4][2], B0[2][2], B1[2][2];
    const char* A0 = (const char*)g.A;
    const char* cB = (const char*)g.Bt + (size_t)S.b_row0(cur) * K * 2;
    unsigned aoc[2][2], aon[2][2];
    PG8_AOFFS(aoc, cur);
    PG8_STAGE(PG8_SB(0, 0), cB, voffB); PG8_STAGE(PG8_SB(0, 1), cB + hstep, voffB); PG8_STAGE(PG8_SA(0, 0), A0, aoc[0]); PG8_STAGE(PG8_SA(0, 1), A0, aoc[1]);
    if (wr == 1) PG8_BAR;
    PG8_WAIT_V(2); PG8_BAR;
    PG8_STAGE(PG8_SB(1, 0), cB + kstep, voffB); PG8_STAGE(PG8_SA(1, 0), A0 + kstep, aoc[0]); PG8_STAGE(PG8_SB(1, 1), cB + hstep + kstep, voffB);
    PG8_WAIT_V(6); PG8_BAR;
    for (;;) {
        const bool has_next = S.next(ui + 1, nxt);
        const char* nB = has_next ? (const char*)g.Bt + (size_t)S.b_row0(nxt) * K * 2 : cB;
        if (has_next) { PG8_AOFFS(aon, nxt); } else {
#pragma unroll
            for (int h = 0; h < 2; ++h)
#pragma unroll
                for (int i = 0; i < 2; ++i) aon[h][i] = aoc[h][i]; }
        for (int t = 0; t < nt; t += 2) {
            const bool last = (t == nt - 2);
            const char* a1 = A0 + (size_t)(t + 1) * kstep;
            const char* a2 = last ? A0 : A0 + (size_t)(t + 2) * kstep; const char* b2 = last ? nB : cB + (size_t)(t + 2) * kstep;
            const char* a3 = a2 + kstep; const char* b3 = b2 + kstep;
            unsigned ao2[2][2];
#pragma unroll
            for (int h = 0; h < 2; ++h)
#pragma unroll
                for (int i = 0; i < 2; ++i) ao2[h][i] = last ? aon[h][i] : aoc[h][i];
            PG8_LDB(B0, 0, 0); PG8_LDB(B1, 0, 1); PG8_SCHED; PG8_LDA(At, 0, 0); PG8_STAGE(PG8_SA(1, 1), a1, aoc[1]);
            PG8_WAIT_V(8); PG8_WAIT_L(0); PG8_BAR; PG8_MMA(0, 0, At, B0); PG8_MMA(0, 1, At, B1); PG8_BAR; PG8_SCHED;
            PG8_LDA(At, 0, 1); PG8_STAGE(PG8_SB(0, 0), b2, voffB); PG8_STAGE(PG8_SB(0, 1), b2 + hstep, voffB); PG8_STAGE(PG8_SA(0, 0), a2, ao2[0]);
            PG8_WAIT_V(8); PG8_WAIT_L(0); PG8_BAR; PG8_MMA(1, 0, At, B0); PG8_MMA(1, 1, At, B1); PG8_BAR; PG8_SCHED;
            PG8_LDB(B0, 1, 0); PG8_LDB(B1, 1, 1); PG8_SCHED; PG8_LDA(At, 1, 0); PG8_STAGE(PG8_SA(0, 1), a2, ao2[1]);
            PG8_WAIT_V(8); PG8_WAIT_L(0); PG8_BAR; PG8_MMA(0, 0, At, B0); PG8_MMA(0, 1, At, B1); PG8_BAR; PG8_SCHED;
            PG8_LDA(At, 1, 1); PG8_STAGE(PG8_SB(1, 0), b3, voffB); PG8_STAGE(PG8_SB(1, 1), b3 + hstep, voffB); PG8_STAGE(PG8_SA(1, 0), a3, ao2[0]);
            PG8_WAIT_V(8); PG8_WAIT_L(0); PG8_BAR; PG8_MMA(1, 0, At, B0); PG8_MMA(1, 1, At, B1); PG8_BAR; PG8_SCHED;
        }
        if (wr == 0) PG8_BAR;
        E(acc, cur, wr, wc, fr, fq);
        if (!has_next) break;
#pragma unroll
        for (int a = 0; a < 2; ++a)
#pragma unroll
            for (int b = 0; b < 2; ++b)
#pragma unroll
                for (int m = 0; m < 4; ++m)
#pragma unroll
                    for (int n = 0; n < 2; ++n) acc[a][b][m][n] = (f32x4){0.f, 0.f, 0.f, 0.f};
        cur = nxt; cB = nB; ++ui;
#pragma unroll
        for (int h = 0; h < 2; ++h)
#pragma unroll
            for (int i = 0; i < 2; ++i) aoc[h][i] = aon[h][i];
        if (wr == 1) PG8_BAR;
    }
    PG8_WAIT_V(0);
    PG8_BAR;
#undef PG8_SA
#undef PG8_SB
#undef PG8_STAGE
#undef PG8_AOFFS
#undef PG8_LDA
#undef PG8_LDB
#undef PG8_MMA
#undef PG8_WAIT_V
#undef PG8_WAIT_L
#undef PG8_BAR
#undef PG8_SCHED
}
}

#define GAS __attribute__((address_space(1)))
#define LAS __attribute__((address_space(3)))
typedef unsigned short bf16;
typedef unsigned v4u __attribute__((ext_vector_type(4)));
typedef float f32x4 __attribute__((ext_vector_type(4)));
typedef short bf16x8 __attribute__((ext_vector_type(8)));
typedef GAS unsigned gu32;
typedef GAS unsigned long long gu64;
#define RLX_AGENT __ATOMIC_RELAXED, __HIP_MEMORY_SCOPE_AGENT
#define LDS_WAIT() asm volatile("s_waitcnt lgkmcnt(0)" ::: "memory")
#define VM_WAIT() asm volatile("s_waitcnt vmcnt(0)" ::: "memory")
__device__ __forceinline__ unsigned long long rt() { return __builtin_amdgcn_s_memrealtime(); }
__device__ __forceinline__ unsigned f2bf(float f) { unsigned u = __builtin_bit_cast(unsigned, f); return (u + 0x7fffu + ((u >> 16) & 1u)) >> 16; }
__device__ __forceinline__ unsigned pk2(float lo, float hi) { return f2bf(lo) | (f2bf(hi) << 16); }

#define XB_TMO      128
#define XB_XCNT(j)  (256  + 64 * (j))
#define XB_XSUB(j)  (1280 + 64 * (j))
#define XB_XGEN(j)  (2304 + 64 * (j))
#define XB_TOP      3328
#define XB_TOPGEN   3392
#define XCD_BAR_WORDS 3456
#define XB_SPIN_CAP (1u << 18)

__device__ __forceinline__ unsigned xb_ld(unsigned* p)              { return __hip_atomic_load(p, __ATOMIC_RELAXED, __HIP_MEMORY_SCOPE_AGENT); }
__device__ __forceinline__ unsigned xb_add(unsigned* p, unsigned v) { return __hip_atomic_fetch_add(p, v, __ATOMIC_RELAXED, __HIP_MEMORY_SCOPE_AGENT); }
__device__ __forceinline__ unsigned xb_xcc_id() { return (unsigned)__builtin_amdgcn_s_getreg((3 << 11) | 20) & 0xFu; }
#define XB_SPIN(cond, bar) do { unsigned _sp = 0; while (cond) { __builtin_amdgcn_s_sleep(1); \
    if ((++_sp & 255u) == 0u) { if (xb_ld(&(bar)[XB_TMO])) break; if (_sp > XB_SPIN_CAP) { atomicAdd(&(bar)[XB_TMO], 1u); break; } } } } while (0)

struct XcdBarrier {
    unsigned* bar; unsigned x;
    volatile LAS unsigned* st;
};

__device__ __forceinline__ XcdBarrier xcd_barrier_post(unsigned* bar, volatile LAS unsigned* st) {
    XcdBarrier b; b.bar = bar; b.x = xb_xcc_id(); b.st = st;
    if (threadIdx.x == 0) (void)xb_add(&bar[XB_XCNT(b.x)], 1u);
    return b;
}
__device__ __forceinline__ void xcd_barrier_complete(unsigned* bar, unsigned x, unsigned& nloc, unsigned& nx) {
    const unsigned G = gridDim.x * gridDim.y * gridDim.z;
    unsigned sum, cnt, mine, sp = 0u;
    for (;;) {
        sum = 0u; cnt = 0u; mine = 0u;
#pragma unroll
        for (unsigned j = 0; j < 16; ++j) { const unsigned c = xb_ld(&bar[XB_XCNT(j)]); sum += c; cnt += (c > 0u) ? 1u : 0u; mine = (j == x) ? c : mine; }
        if (sum == G) break;
        __builtin_amdgcn_s_sleep(1);
        if ((++sp & 255u) == 0u) { if (xb_ld(&bar[XB_TMO])) break; if (sp > XB_SPIN_CAP) { atomicAdd(&bar[XB_TMO], 1u); break; } }
    }
    nloc = mine > 0u ? mine : 1u; nx = cnt > 0u ? cnt : 1u;
}

__device__ __forceinline__ void xcd_barrier(const XcdBarrier& b) {
    asm volatile("s_waitcnt vmcnt(0)" ::: "memory");
    __syncthreads();
    if (threadIdx.x == 0) {
        unsigned* bar = b.bar;
        __builtin_amdgcn_s_waitcnt(0);
        unsigned nloc = b.st[0], nx = b.st[1];
        if (nloc == 0u) { xcd_barrier_complete(bar, b.x, nloc, nx); b.st[0] = nloc; b.st[1] = nx; }
        const unsigned old = xb_add(&bar[XB_XSUB(b.x)], 1u);
        const unsigned gen = old / nloc;
        if (old + 1u == (gen + 1u) * nloc) {
            __builtin_amdgcn_fence(__ATOMIC_RELEASE, "agent");
            asm volatile("s_waitcnt vmcnt(0)" ::: "memory");
            const unsigned og = xb_add(&bar[XB_TOP], 1u);
            const unsigned tg = og / nx;
            if (og + 1u == (tg + 1u) * nx) xb_add(&bar[XB_TOPGEN], 1u);
            else XB_SPIN(xb_ld(&bar[XB_TOPGEN]) == tg, bar);
            __builtin_amdgcn_fence(__ATOMIC_ACQUIRE, "agent");
            xb_add(&bar[XB_XGEN(b.x)], 1u);
            asm volatile("s_waitcnt vmcnt(0)" ::: "memory");
        } else {
            XB_SPIN(xb_ld(&bar[XB_XGEN(b.x)]) == gen, bar);
            __builtin_amdgcn_fence(__ATOMIC_ACQUIRE, "agent");
            asm volatile("s_waitcnt vmcnt(0)" ::: "memory");
        }
    }
    __syncthreads();
}
constexpr int NWAVES = 8;
constexpr int RING_OFF = 0, RING_BYTES = 147456;
constexpr int MISC_OFF = RING_BYTES;
constexpr int LDS_BYTES = 151552;
typedef float f32x2 __attribute__((ext_vector_type(2)));
typedef unsigned u32x2 __attribute__((ext_vector_type(2)));

__device__ __forceinline__ float wave_sum(float v) {
#pragma unroll
    for (int o = 1; o < 64; o <<= 1) v += __shfl_xor(v, o);
    return v;
}
__device__ __forceinline__ float sigmoidf_(float x) { return 1.0f / (1.0f + __expf(-x)); }
__device__ __forceinline__ float siluf_(float x) { return x / (1.0f + __expf(-x)); }
__device__ __forceinline__ float gelu_tanh(float x) { const float u = 0.7978845608028654f * (x + 0.044715f * x * x * x); const float e = __expf(2.0f * u); const float th = 1.0f - 2.0f / (e + 1.0f); return 0.5f * x * (1.0f + th); }

__device__ __forceinline__ void tr_item(const float* W, int ldw, int k0, int n0, int nvalid, bf16* dst, int dld, int drow0, LAS float* scr, int lane) {
    const int nn = lane & 31;
#pragma unroll 8
    for (int i = 0; i < 32; ++i) { const int kk = 2 * i + (lane >> 5); scr[kk * 33 + nn] = (nn < nvalid) ? W[(size_t)(k0 + kk) * ldw + n0 + nn] : 0.f; }
    LDS_WAIT(); asm volatile("" ::: "memory");
    const int c = lane & 7;
#pragma unroll
    for (int j = 0; j < 4; ++j) { const int n = (lane >> 3) + 8 * j; const LAS float* s = scr + (8 * c) * 33 + n;
        v4u o; o.x = pk2(s[0 * 33], s[1 * 33]); o.y = pk2(s[2 * 33], s[3 * 33]); o.z = pk2(s[4 * 33], s[5 * 33]); o.w = pk2(s[6 * 33], s[7 * 33]);
        if (n < nvalid) *(GAS v4u*)(dst + (size_t)(drow0 + n) * dld + k0 + 8 * c) = o; }
    LDS_WAIT(); asm volatile("" ::: "memory");
}
struct P0Args { const float *c, *w_in, *ck_w1, *cv_w1, *ck_pos, *cv_pos, *w_out0, *w_q1, *w_kv, *w_out1, *moe_g, *moe_u, *moe_d, *ada_w, *ada_b; unsigned char* ws; };
__device__ __forceinline__ void p0_transposes(const P0Args& a, LAS unsigned char* lds, int gw, int ngw, int wave, int lane) {
    LAS float* scr = (LAS float*)(lds + 49152 + wave * 8704);
    constexpr int I_WIN = 16 * 82, I_CW = 512, I_SQ = 512, I_KV = 256, I_MOE = 4096;
    constexpr int NITEMS = I_WIN + I_CW + 3 * I_SQ + I_KV + 3 * I_MOE;
    unsigned char* ws = a.ws;
    for (int it = gw; it < NITEMS; it += ngw) {
        int r = it;
        if (r < I_WIN) { const int kb = r / 82, nb = r % 82; const int n0 = nb * 32; const int nv = (NSA_IN - n0) < 32 ? (NSA_IN - n0) : 32;
            tr_item(a.w_in, NSA_IN, kb * 64, n0, nv, (bf16*)(ws + WS_WIN), 1024, n0, scr, lane); continue; } r -= I_WIN;
        if (r < I_CW) { const int tz = r >> 8, hf = (r >> 7) & 1, q = r & 127, kb = q >> 3, nb = q & 7;
            const float* W = (tz ? a.cv_w1 : a.ck_w1) + (size_t)hf * 1024 * 256;
            tr_item(W, 256, kb * 64, nb * 32, 32, (bf16*)(ws + WS_CW1) + (size_t)tz * 512 * 1024, 1024, hf * 256 + nb * 32, scr, lane); continue; } r -= I_CW;
        if (r < I_SQ) { tr_item(a.w_out0, 1024, (r >> 5) * 64, (r & 31) * 32, 32, (bf16*)(ws + WS_WOUT0), 1024, (r & 31) * 32, scr, lane); continue; } r -= I_SQ;
        if (r < I_SQ) { tr_item(a.w_q1, 1024, (r >> 5) * 64, (r & 31) * 32, 32, (bf16*)(ws + WS_WQ1), 1024, (r & 31) * 32, scr, lane); continue; } r -= I_SQ;
        if (r < I_KV) { tr_item(a.w_kv, 512, (r >> 4) * 64, (r & 15) * 32, 32, (bf16*)(ws + WS_WKV), 1024, (r & 15) * 32, scr, lane); continue; } r -= I_KV;
        if (r < I_SQ) { tr_item(a.w_out1, 1024, (r >> 5) * 64, (r & 31) * 32, 32, (bf16*)(ws + WS_WOUT1), 1024, (r & 31) * 32, scr, lane); continue; } r -= I_SQ;
        if (r < 2 * I_MOE) { const int up = r >= I_MOE; const int q = up ? r - I_MOE : r; const int le = q >> 7, w = q & 127, kb = w >> 3, nb = w & 7; const int n0 = nb * 32;
            const float* W = (up ? a.moe_u : a.moe_g) + (size_t)le * 1024 * 256;
            tr_item(W, 256, kb * 64, n0, 32, (bf16*)(ws + WS_WGU) + (size_t)le * 512 * 1024, 1024, (n0 >> 7) * 256 + (up ? 128 : 0) + (n0 & 127), scr, lane); continue; } r -= 2 * I_MOE;
        { const int le = r >> 7, w = r & 127, kb = w >> 5, nb = w & 31;
            tr_item(a.moe_d + (size_t)le * 256 * 1024, 1024, kb * 64, nb * 32, 32, (bf16*)(ws + WS_WD) + (size_t)le * 1024 * 256, 256, nb * 32, scr, lane); }
    }
}
__device__ __forceinline__ void p0_small(const P0Args& a, LAS unsigned char* lds, int blk, int nblk, int tid) {
    LAS float* cond = (LAS float*)lds;
    LAS float* part = (LAS float*)(lds + 32768);
    const int col = tid & 63, ks = tid >> 6;
    for (int u = blk; u < 200 + 26; u += nblk) {
        if (u < 192) {
            for (int i = tid; i < 8192; i += 512) cond[i] = siluf_(a.c[i]);
            __syncthreads();
            const int layer = u / 96, c0 = (u % 96) * 64;
            const float* W = a.ada_w + (size_t)layer * 1024 * 6144 + c0 + col;
            float acc[8];
#pragma unroll
            for (int b = 0; b < 8; ++b) acc[b] = 0.f;
#pragma unroll 8
            for (int k = ks * 128; k < ks * 128 + 128; ++k) { const float w = W[(size_t)k * 6144];
#pragma unroll
                for (int b = 0; b < 8; ++b) acc[b] += cond[b * 1024 + k] * w; }
#pragma unroll
            for (int b = 0; b < 8; ++b) part[(ks * 8 + b) * 64 + col] = acc[b];
            __syncthreads();
            { const int b = tid >> 6; float s = 0.f;
#pragma unroll
              for (int k2 = 0; k2 < 8; ++k2) s += part[(k2 * 8 + b) * 64 + col];
              ((float*)(a.ws + WS_ADA))[(size_t)(layer * 8 + b) * 6144 + c0 + col] = s + a.ada_b[layer * 6144 + c0 + col]; }
            __syncthreads();
        } else if (u < 200) {
            const int tz = (u - 192) >> 2, c0 = ((u - 192) & 3) * 64;
            const float* W = (tz ? a.cv_w1 : a.ck_w1) + c0 + col; const float* pos = tz ? a.cv_pos : a.ck_pos;
            float acc = 0.f;
#pragma unroll 8
            for (int k = ks * 256; k < ks * 256 + 256; ++k) acc += pos[k] * W[(size_t)k * 256];
            part[ks * 64 + col] = acc;
            __syncthreads();
            if (tid < 64) { float s = 0.f;
#pragma unroll
                for (int k2 = 0; k2 < 8; ++k2) s += part[k2 * 64 + tid];
                ((float*)(a.ws + WS_POSB))[tz * 256 + c0 + tid] = s; }
            __syncthreads();
        } else {
            const int sl = u - 200; GAS v4u* p = (GAS v4u*)(a.ws + WS_WIN + (size_t)NSA_IN * 2048) + sl * 1024;
            for (int i = tid; i < 1024; i += 512) p[i] = (v4u){0u, 0u, 0u, 0u};
        }
    }
}

struct RowVec { f32x4 v[4]; };
__device__ __forceinline__ RowVec ld_row_f32(const float* p, int lane) { RowVec r; const GAS f32x4* q = (const GAS f32x4*)p + lane;
#pragma unroll
    for (int j = 0; j < 4; ++j) r.v[j] = q[64 * j]; return r; }
__device__ __forceinline__ void st_row_f32(float* p, int lane, const RowVec& r) { GAS f32x4* q = (GAS f32x4*)p + lane;
#pragma unroll
    for (int j = 0; j < 4; ++j) q[64 * j] = r.v[j]; }
__device__ __forceinline__ RowVec ld_row_bf16(const bf16* p, int lane) { RowVec r; const GAS u32x2* q = (const GAS u32x2*)p + lane;
#pragma unroll
    for (int j = 0; j < 4; ++j) { const u32x2 w = q[64 * j]; r.v[j] = (f32x4){__uint_as_float(w.x << 16), __uint_as_float(w.x & 0xffff0000u), __uint_as_float(w.y << 16), __uint_as_float(w.y & 0xffff0000u)}; } return r; }
__device__ __forceinline__ void st_row_bf16(bf16* p, int lane, const RowVec& r) { GAS u32x2* q = (GAS u32x2*)p + lane;
#pragma unroll
    for (int j = 0; j < 4; ++j) { u32x2 w; w.x = pg8::cvt_pk_bf16(r.v[j].x, r.v[j].y); w.y = pg8::cvt_pk_bf16(r.v[j].z, r.v[j].w); q[64 * j] = w; } }
__device__ __forceinline__ RowVec layer_norm_row(const RowVec& in, const RowVec& g, const RowVec& b) {
    float s = 0.f;
#pragma unroll
    for (int j = 0; j < 4; ++j) s += (in.v[j].x + in.v[j].y) + (in.v[j].z + in.v[j].w);
    const float mean = wave_sum(s) * (1.f / DM); float s2 = 0.f; RowVec d;
#pragma unroll
    for (int j = 0; j < 4; ++j) { d.v[j] = in.v[j] - mean; s2 += (d.v[j].x * d.v[j].x + d.v[j].y * d.v[j].y) + (d.v[j].z * d.v[j].z + d.v[j].w * d.v[j].w); }
    const float rstd = 1.f / sqrtf(wave_sum(s2) * (1.f / DM) + LN_EPS_F);
#pragma unroll
    for (int j = 0; j < 4; ++j) d.v[j] = d.v[j] * rstd * g.v[j] + b.v[j];
    return d;
}
__device__ __forceinline__ const float* ada_vec(const unsigned char* ws, int layer, int b, int k) { return (const float*)(ws + WS_ADA) + (size_t)(layer * 8 + b) * 6144 + k * 1024; }

__device__ __forceinline__ void p_modulate(const float* x, unsigned char* ws, int layer, bf16* hb, int gw, int ngw, int lane) {
    const int rpw = NT / ngw;
    const int r0 = gw * rpw, b = r0 >> 12;
    const RowVec sh = ld_row_f32(ada_vec(ws, layer, b, 0), lane), sc = ld_row_f32(ada_vec(ws, layer, b, 1), lane);
    for (int m = r0; m < r0 + rpw; ++m) { RowVec v = ld_row_f32(x + (size_t)m * DM, lane);
#pragma unroll
        for (int j = 0; j < 4; ++j) v.v[j] = v.v[j] * (1.0f + sc.v[j]) + sh.v[j];
        st_row_bf16(hb + (size_t)m * DM, lane, v); }
}

struct LnRouterArgs { const float* xin; const bf16* xinb; const bf16* mix; bf16* x1b; bf16* h2; const float* ln_g; const float* ln_b; const float* router_w; const float* router_b; unsigned char* ws; int layer; unsigned* cnt; };
template <bool XBF> __device__ __forceinline__ void p_ln_router(const LnRouterArgs& a, LAS unsigned char* lds, int blk, int nblk, int tid) {
    typedef float f32x4v __attribute__((ext_vector_type(4)));
    const int lane = tid & 63, wave = __builtin_amdgcn_readfirstlane(tid >> 6);
    LAS float* Tt = (LAS float*)lds;
    LAS float* Pp = (LAS float*)(lds + 66048);
    LAS float* Ss = (LAS float*)(lds + 66048 + 8192);
    LAS unsigned* tokE = (LAS unsigned*)(lds + 66048 + 8192 + 1024);
    LAS unsigned* lcnt = tokE + 256;
    LAS unsigned* lbase = lcnt + 16;
    LAS float* rbl = (LAS float*)(lbase + 16);
    const int rows_per_blk = NT / nblk;
    const int row0 = blk * rows_per_blk, b = row0 >> 12;
    if (tid < 16) { lcnt[tid] = 0u; rbl[tid] = a.router_b[tid]; }
    float wreg[32];
#pragma unroll
    for (int i = 0; i < 32; ++i) wreg[i] = a.router_w[(size_t)(128 * wave + 4 * i + (lane >> 4)) * 16 + (lane & 15)];
    const RowVec ga = ld_row_f32(ada_vec(a.ws, a.layer, b, 2), lane), shf = ld_row_f32(ada_vec(a.ws, a.layer, b, 3), lane), scf = ld_row_f32(ada_vec(a.ws, a.layer, b, 4), lane);
    const RowVec lg = ld_row_f32(a.ln_g, lane), lb = ld_row_f32(a.ln_b, lane);
    float* tokw = (float*)(a.ws + WS_TOKW);
    RowVec nx[XBF ? 1 : 2]; u32x2 nxb[XBF ? 2 : 1][4]; u32x2 nmr[2][4];
#define LNR_LOAD(G0) _Pragma("unroll") for (int rr = 0; rr < 2; ++rr) { const size_t m_ = (size_t)((G0) + 2 * wave + rr); \
        if (XBF) { const GAS u32x2* x_ = (const GAS u32x2*)(a.xinb + m_ * DM) + lane; _Pragma("unroll") for (int j = 0; j < 4; ++j) nxb[XBF ? rr : 0][j] = x_[64 * j]; } else nx[XBF ? 0 : rr] = ld_row_f32(a.xin + m_ * DM, lane); \
        const GAS u32x2* q_ = (const GAS u32x2*)(a.mix + m_ * DM) + lane; _Pragma("unroll") for (int j = 0; j < 4; ++j) nmr[rr][j] = q_[64 * j]; }
    LNR_LOAD(row0)
    for (int grp = 0; grp < rows_per_blk / 16; ++grp) {
        const int g0 = row0 + grp * 16;
#pragma unroll
        for (int rr = 0; rr < 2; ++rr) { const int lr = 2 * wave + rr; const size_t m = (size_t)(g0 + lr);
            RowVec xv, mv;
            if (XBF) {
#pragma unroll
                for (int j = 0; j < 4; ++j) { const u32x2 w = nxb[XBF ? rr : 0][j]; xv.v[j] = (f32x4){__uint_as_float(w.x << 16), __uint_as_float(w.x & 0xffff0000u), __uint_as_float(w.y << 16), __uint_as_float(w.y & 0xffff0000u)}; }
            } else xv = nx[XBF ? 0 : rr];
#pragma unroll
            for (int j = 0; j < 4; ++j) { const u32x2 w = nmr[rr][j]; mv.v[j] = (f32x4){__uint_as_float(w.x << 16), __uint_as_float(w.x & 0xffff0000u), __uint_as_float(w.y << 16), __uint_as_float(w.y & 0xffff0000u)}; }
#pragma unroll
            for (int j = 0; j < 4; ++j) xv.v[j] = ALPHA_F * xv.v[j] + (1.0f + ga.v[j]) * mv.v[j];
            RowVec y = layer_norm_row(xv, lg, lb);
            st_row_bf16(a.x1b + m * DM, lane, y);
#pragma unroll
            for (int j = 0; j < 4; ++j) y.v[j] = y.v[j] * (1.0f + scf.v[j]) + shf.v[j];
            st_row_bf16(a.h2 + m * DM, lane, y);
#pragma unroll
            for (int j = 0; j < 4; ++j) *(LAS f32x4v*)(Tt + lr * 1028 + 4 * lane + 256 * j) = y.v[j];
        }
        if (grp + 1 < rows_per_blk / 16) { LNR_LOAD(g0 + 16) }
        __syncthreads();
        { f32x4v acc = {0.f, 0.f, 0.f, 0.f}; const LAS float* ap = Tt + (lane & 15) * 1028 + 128 * wave + (lane >> 4);
#pragma unroll
          for (int i = 0; i < 32; ++i) acc = __builtin_amdgcn_mfma_f32_16x16x4f32(ap[4 * i], wreg[i], acc, 0, 0, 0);
#pragma unroll
          for (int r = 0; r < 4; ++r) Pp[(wave * 16 + 4 * (lane >> 4) + r) * 16 + (lane & 15)] = acc[r]; }
        __syncthreads();
        if (tid < 256) {
            float s = 0.f;
#pragma unroll
            for (int w = 0; w < 8; ++w) s += Pp[w * 256 + tid];
            s = sigmoidf_(s);
            const int e = tid & 15, tk = tid >> 4, qi = lane & 3;
            const float v = s + rbl[e];
            int rank = 0;
#pragma unroll
            for (int r = 1; r < 4; ++r) { const int oi = (qi + r) & 3; const float ov = __shfl(v, (lane & ~3) | oi); rank += (ov > v || (ov == v && oi < qi)) ? 1 : 0; }
            float gs = rank < 2 ? v : 0.f, ws2 = rank < 2 ? s : 0.f;
            gs += __shfl_xor(gs, 1); gs += __shfl_xor(gs, 2); ws2 += __shfl_xor(ws2, 1); ws2 += __shfl_xor(ws2, 2);
            const int gi = (lane >> 2) & 3; int grank = 0;
#pragma unroll
            for (int r = 1; r < 4; ++r) { const int og = (gi + r) & 3; const float ogs = __shfl(gs, (lane & ~15) | (og << 2) | qi); grank += (ogs > gs || (ogs == gs && og < gi)) ? 1 : 0; }
            if (grank == 0 && rank < 2) { const int m = g0 + tk;
                tokw[(size_t)m * 2 + rank] = s / ws2;
                const unsigned p = atomicAdd((unsigned*)&lcnt[e], 1u);
                tokE[(grp * 16 + tk) * 2 + rank] = (unsigned)e | (p << 8); }
        }
        __syncthreads();
    }
    if (tid < 16) lbase[tid] = __hip_atomic_fetch_add(a.cnt + tid, lcnt[tid], __ATOMIC_RELAXED, __HIP_MEMORY_SCOPE_AGENT);
    __syncthreads();
    if (tid < 2 * rows_per_blk) { const unsigned en = tokE[tid]; const unsigned e = en & 255u, lp = en >> 8;
        const unsigned tk = (unsigned)(row0 + (tid >> 1)) * 2u + (unsigned)(tid & 1);
        ((unsigned*)(a.ws + WS_LIST))[(size_t)e * NT + lbase[e] + lp] = tk;
        ((unsigned*)(a.ws + WS_TOKPOS))[tk] = e | ((lbase[e] + lp) << 8); }
    __syncthreads();
}

#undef LNR_LOAD
template <bool FINAL> __device__ __forceinline__ void p_ln_ffn(const float* xin, const bf16* xinb, float* xout, const bf16* mix, const unsigned char* y, const float* ln_g1, const float* ln_b1, const float* ln_g_, const float* ln_b_, unsigned char* ws, int layer, bf16* xb, bf16* hb, const unsigned* cnt, LAS unsigned char* lds, int gw, int ngw, int tid) {
    constexpr bool prep = !FINAL;
    const int lane = tid & 63;
    LAS int* tb = (LAS int*)lds;
    if (tid < 16) { int base = 0; for (int e = 0; e < tid; ++e) base += ((int)cnt[e] + 255) >> 8; tb[tid] = base; }
    __syncthreads();
    const int rpw = NT / ngw; const int r0 = gw * rpw, b = r0 >> 12;
    const RowVec gf = ld_row_f32(ada_vec(ws, layer, b, 5), lane), lg = ld_row_f32(ln_g_, lane), lb = ld_row_f32(ln_b_, lane);
    RowVec sh, sc;
    if (prep) { sh = ld_row_f32(ada_vec(ws, layer + 1, b, 0), lane); sc = ld_row_f32(ada_vec(ws, layer + 1, b, 1), lane); }
    const unsigned* tokpos = (const unsigned*)(ws + WS_TOKPOS); const float* tokw_ = (const float*)(ws + WS_TOKW);
    const int li = lane < 2 * rpw ? lane : 0; const unsigned tpv = tokpos[2 * r0 + li]; const float twv = tokw_[2 * r0 + li];
    const unsigned yrow_l = (unsigned)tb[tpv & 255u] * 256u + (tpv >> 8);
    struct RowIn { u32x2 xr[4]; unsigned ya[4], yb[4]; };
    auto load_row = [&](int k) { RowIn r; const int m = r0 + k;
        const unsigned y0 = (unsigned)__builtin_amdgcn_readlane((int)yrow_l, 2 * k), y1 = (unsigned)__builtin_amdgcn_readlane((int)yrow_l, 2 * k + 1);
        const GAS u32x2* xp = (const GAS u32x2*)(xinb + (size_t)m * DM) + lane;
        const GAS unsigned* ap = (const GAS unsigned*)(y + (size_t)y0 * DM) + lane; const GAS unsigned* bp = (const GAS unsigned*)(y + (size_t)y1 * DM) + lane;
#pragma unroll
        for (int j = 0; j < 4; ++j) { r.xr[j] = xp[64 * j]; r.ya[j] = ap[64 * j]; r.yb[j] = bp[64 * j]; }
        return r; };
#define F8x4(w_) ([](unsigned q_) { const auto lo_ = __builtin_amdgcn_cvt_pk_f32_fp8((int)q_, false); const auto hi_ = __builtin_amdgcn_cvt_pk_f32_fp8((int)q_, true); return (f32x4){lo_[0], lo_[1], hi_[0], hi_[1]}; }(w_))
#define BF4(w_) ((f32x4){__uint_as_float((w_).x << 16), __uint_as_float((w_).x & 0xffff0000u), __uint_as_float((w_).y << 16), __uint_as_float((w_).y & 0xffff0000u)})
    RowIn cur = load_row(0);
#pragma unroll 1
    for (int k = 0; k < rpw; ++k) {
        RowIn nxt = cur; if (k + 1 < rpw) nxt = load_row(k + 1);
        const int m = r0 + k;
        const float w0 = __int_as_float(__builtin_amdgcn_readlane(__float_as_int(twv), 2 * k)), w1 = __int_as_float(__builtin_amdgcn_readlane(__float_as_int(twv), 2 * k + 1));
        RowVec xv;
#pragma unroll
        for (int j = 0; j < 4; ++j) xv.v[j] = ALPHA_F * BF4(cur.xr[j]) + (1.0f + gf.v[j]) * (w0 * F8x4(cur.ya[j]) + w1 * F8x4(cur.yb[j]));
        RowVec yv = layer_norm_row(xv, lg, lb);
        if (FINAL) st_row_f32(xout + (size_t)m * DM, lane, yv);
        if (prep) { st_row_bf16(xb + (size_t)m * DM, lane, yv);
#pragma unroll
            for (int j = 0; j < 4; ++j) yv.v[j] = yv.v[j] * (1.0f + sc.v[j]) + sh.v[j];
            st_row_bf16(hb + (size_t)m * DM, lane, yv); }
        cur = nxt;
    }
#undef BF4
#undef F8x4
    __syncthreads();
}

__device__ __forceinline__ void p_cmp_tail(const float* w2k, const float* w2v, unsigned char* ws, LAS unsigned char* lds, int blk, int nblk, int tid) {
    typedef float f32x4v __attribute__((ext_vector_type(4)));
    LAS float* W2 = (LAS float*)lds;
    LAS float* Hd = (LAS float*)(lds + 65536);
    const float* UL = (const float*)(ws + WS_UL);
    for (int u = blk; u < 512; u += nblk) {
        const int tz = u >> 8, bg = (u >> 3) & 31, ch = u & 7;
        const float* w2 = tz ? w2v : w2k; const float* posb = (const float*)(ws + WS_POSB) + tz * 256;
        for (int i = tid; i < 4096; i += 512) *(LAS f32x4v*)(W2 + 4 * i) = *(const GAS f32x4v*)(w2 + 4 * i);
        for (int i = tid; i < 32 * 64; i += 512) { const int n = i >> 6, c4 = (i & 63) * 4; const int nn = ch * 32 + n; const size_t R = (size_t)tz * 8192 + bg * 256 + nn;
            f32x4v h = {0.f, 0.f, 0.f, 0.f};
            if (nn < 255) { const f32x4v uu = *(const GAS f32x4v*)(UL + R * 512 + c4), ll = *(const GAS f32x4v*)(UL + (R + 1) * 512 + 256 + c4), pb = *(const GAS f32x4v*)(posb + c4);
                h.x = gelu_tanh(uu.x + ll.x + pb.x); h.y = gelu_tanh(uu.y + ll.y + pb.y); h.z = gelu_tanh(uu.z + ll.z + pb.z); h.w = gelu_tanh(uu.w + ll.w + pb.w); }
            *(LAS f32x4v*)(Hd + n * 260 + c4) = h; }
        __syncthreads();
        { const int n = tid >> 4, dq = tid & 15; f32x4v acc = {0.f, 0.f, 0.f, 0.f};
#pragma unroll 8
          for (int c = 0; c < 256; ++c) { const float h = Hd[n * 260 + c]; const f32x4v w = *(const LAS f32x4v*)(W2 + c * 64 + 4 * dq); acc += h * w; }
          bf16* dst = (bf16*)(ws + (tz ? WS_VCMP : WS_KCMP)) + ((size_t)bg * 256 + ch * 32 + n) * 64 + 4 * dq;
          u32x2 o; o.x = pk2(acc.x, acc.y); o.y = pk2(acc.z, acc.w); *(GAS u32x2*)dst = o; }
        __syncthreads();
    }
}

namespace att {
typedef float f32x16 __attribute__((ext_vector_type(16)));
typedef short s16x4 __attribute__((ext_vector_type(4)));
constexpr int NSLOT = 6, SLOT_B = 16384;
constexpr int TSZ = 640;
constexpr int L_RING = 0, L_TB = NSLOT * SLOT_B, L_P4 = L_TB + TSZ * 8, L_P3 = L_P4 + 16384, L_SEL = L_P3 + 16384, L_NEXT = L_SEL + 512, L_END = L_NEXT + 16;
static_assert(L_END <= RING_BYTES, "attention LDS");
constexpr unsigned short TB_MASK = 0xF14Au;
constexpr float MASK_TEST = -1e29f;
constexpr float THR = 8.0f;
__device__ const unsigned char BUCKET[129] = {0, 1, 2, 3, 4, 5, 6, 7, 8, 9, 10, 11, 12, 13, 14, 15, 16, 16, 16, 17, 17, 18, 18, 18, 19, 19, 19, 20, 20, 20, 20, 21, 21, 21, 21, 22, 22, 22, 22, 22, 23, 23, 23, 23, 23, 23, 24, 24, 24, 24, 24, 24, 25, 25, 25, 25, 25, 25, 25, 26, 26, 26, 26, 26, 26, 26, 26, 27, 27, 27, 27, 27, 27, 27, 27, 27, 27, 28, 28, 28, 28, 28, 28, 28, 28, 28, 28, 29, 29, 29, 29, 29, 29, 29, 29, 29, 29, 29, 29, 30, 30, 30, 30, 30, 30, 30, 30, 30, 30, 30, 30, 30, 30, 31, 31, 31, 31, 31, 31, 31, 31, 31, 31, 31, 31, 31, 31, 31, 31};
__device__ __forceinline__ int crow(int r, int hi) { return (r & 3) + 8 * (r >> 2) + 4 * hi; }
__device__ __forceinline__ int med3i(int a, int lo, int hi) { return a < lo ? lo : (a > hi ? hi : a); }
__device__ __forceinline__ s16x4 vtr(const LAS unsigned char* p) { return __builtin_bit_cast(s16x4, __builtin_amdgcn_ds_read_tr16_b64_v4i16((LAS s16x4*)p)); }
__device__ __forceinline__ unsigned cvtpk(float lo, float hi) { return pg8::cvt_pk_bf16(lo, hi); }
__device__ __forceinline__ float fadd_s(float a, float b) { float r; asm("v_add_f32_e32 %0, %1, %2" : "=v"(r) : "v"(a), "v"(b)); return r; }
__device__ __forceinline__ float max3f(float a, float b, float c) { return __builtin_fmaxf(__builtin_fmaxf(a, b), c); }
__device__ __forceinline__ void glds16(const void* gsrc, unsigned lds_dst) { unsigned keep;
    asm volatile("s_mov_b32 %0, m0\n\ts_mov_b32 m0, %2\n\ts_nop 0\n\tglobal_load_lds_dwordx4 %1, off\n\ts_mov_b32 m0, %0" : "=&s"(keep) : "v"(gsrc), "s"(lds_dst) : "memory"); }
#define ATT_WAIT_BAR(N) asm volatile("s_waitcnt vmcnt(" #N ") lgkmcnt(0)\n\ts_barrier" ::: "memory")

struct LaneGeo {
    int lane, wid, r32, hi;
    unsigned dma_off;
    unsigned dma_dst;
    int koff[4];
    int voff[2][2];
    static __device__ __forceinline__ int fsw(int row) { return (((row >> 1) & 1) << 2) | ((row >> 2) & 3); }
    __device__ __forceinline__ void init(int tid) {
        lane = tid & 63; wid = __builtin_amdgcn_readfirstlane(tid >> 6); r32 = lane & 31; hi = lane >> 5;
        const int rr = lane >> 3, cc = lane & 7, row = 8 * wid + rr;
        dma_off = (unsigned)(row * 128 + ((cc ^ fsw(row)) * 16));
        dma_dst = (unsigned)(wid * 1024);
#pragma unroll
        for (int d0 = 0; d0 < 4; ++d0) koff[d0] = r32 * 128 + (((2 * d0 + hi) ^ fsw(r32)) * 16);
        const int i16 = lane & 15, g4 = lane >> 4, hh = g4 >> 1, rowl = 4 * hh + (i16 >> 2), ch0 = 2 * (g4 & 1) + ((i16 & 3) >> 1);
#pragma unroll
        for (int dh = 0; dh < 2; ++dh)
#pragma unroll
            for (int t = 0; t < 2; ++t) voff[dh][t] = (8 * t + rowl) * 128 + ((((ch0 + 4 * dh) ^ fsw(8 * t + rowl)) * 16) + 8 * (i16 & 1));
    }
};
__device__ __forceinline__ void dma_tile(const LaneGeo& L, const bf16* gK, const bf16* gV, unsigned lds0, int slot) {
    const unsigned dst = (unsigned)__builtin_amdgcn_readfirstlane((int)(lds0 + L_RING + slot * SLOT_B + L.dma_dst));
    glds16((const char*)gK + L.dma_off, dst); glds16((const char*)gV + L.dma_off, dst + 8192u);
}
__device__ __forceinline__ void qk_tile(f32x16& p0, f32x16& p1, const LAS unsigned char* Ks, const bf16x8 (&qr)[4], const LaneGeo& L, const f32x16& c) {
    bf16x8 a0[4], a1[4];
#pragma unroll
    for (int d0 = 0; d0 < 4; ++d0) { a0[d0] = *(const LAS bf16x8*)(Ks + L.koff[d0]); a1[d0] = *(const LAS bf16x8*)(Ks + L.koff[d0] + 4096); }
    __builtin_amdgcn_s_setprio(1);
    p0 = __builtin_amdgcn_mfma_f32_32x32x16_bf16(a0[0], qr[0], c, 0, 0, 0); p1 = __builtin_amdgcn_mfma_f32_32x32x16_bf16(a1[0], qr[0], c, 0, 0, 0);
#pragma unroll
    for (int d0 = 1; d0 < 4; ++d0) { p0 = __builtin_amdgcn_mfma_f32_32x32x16_bf16(a0[d0], qr[d0], p0, 0, 0, 0); p1 = __builtin_amdgcn_mfma_f32_32x32x16_bf16(a1[d0], qr[d0], p1, 0, 0, 0); }
    __builtin_amdgcn_s_setprio(0);
}
__device__ __forceinline__ float quad_sum(float v) {
    v += __int_as_float(__builtin_amdgcn_mov_dpp(__float_as_int(v), 0xB1, 0xF, 0xF, true));
    v += __int_as_float(__builtin_amdgcn_mov_dpp(__float_as_int(v), 0x4E, 0xF, 0xF, true));
    return v;
}
__device__ __forceinline__ float xhalf_max(float v) { auto rr = __builtin_amdgcn_permlane32_swap(__float_as_uint(v), __float_as_uint(v), false, false); return __builtin_fmaxf(__uint_as_float(rr[0]), __uint_as_float(rr[1])); }
__device__ __forceinline__ float xhalf_sum(float v) { auto rr = __builtin_amdgcn_permlane32_swap(__float_as_uint(v), __float_as_uint(v), false, false); return __uint_as_float(rr[0]) + __uint_as_float(rr[1]); }
__device__ __forceinline__ void softmax_pv(f32x16& p0, f32x16& p1, const LAS unsigned char* Vs, f32x16 (&o)[2], float& m, float& l, f32x16& cini, bool rowok, const LaneGeo& L) {
    float a = max3f(p0[0], p0[1], p1[0]), b = max3f(p0[2], p0[3], p1[1]); a = max3f(a, p1[2], p1[3]);
#pragma unroll
    for (int r = 4; r < 16; r += 4) { a = max3f(a, p0[r], p0[r + 1]); b = max3f(b, p0[r + 2], p0[r + 3]); a = max3f(a, p1[r], p1[r + 1]); b = max3f(b, p1[r + 2], p1[r + 3]); }
    const float mx = xhalf_max(__builtin_fmaxf(a, b));
    const bool grow = rowok && ((mx > THR) || (l == 0.f && mx > MASK_TEST));
    if (__builtin_expect(__any(grow), 0)) {
        const float dl = grow ? mx : 0.f; m += dl; const float f = __builtin_amdgcn_exp2f(-dl); l *= f;
#pragma unroll
        for (int r = 0; r < 16; ++r) { p0[r] -= dl; p1[r] -= dl; o[0][r] *= f; o[1][r] *= f; cini[r] -= dl; }
    }
    float rs0 = 0.f, rs1 = 0.f;
#pragma unroll
    for (int r = 0; r < 16; ++r) { p0[r] = __builtin_amdgcn_exp2f(p0[r]); p1[r] = __builtin_amdgcn_exp2f(p1[r]); rs0 += p0[r]; rs0 += p1[r]; }
    const float rs = xhalf_sum(rs0);
    l += rowok ? rs : 0.f;
    const unsigned km = rowok ? 0xffffffffu : 0u;
    v4u pf[4];
    pf[0] = (v4u){cvtpk(p0[0], p0[1]) & km, cvtpk(p0[2], p0[3]) & km, cvtpk(p0[4], p0[5]) & km, cvtpk(p0[6], p0[7]) & km};
    pf[1] = (v4u){cvtpk(p0[8], p0[9]) & km, cvtpk(p0[10], p0[11]) & km, cvtpk(p0[12], p0[13]) & km, cvtpk(p0[14], p0[15]) & km};
    pf[2] = (v4u){cvtpk(p1[0], p1[1]) & km, cvtpk(p1[2], p1[3]) & km, cvtpk(p1[4], p1[5]) & km, cvtpk(p1[6], p1[7]) & km};
    pf[3] = (v4u){cvtpk(p1[8], p1[9]) & km, cvtpk(p1[10], p1[11]) & km, cvtpk(p1[12], p1[13]) & km, cvtpk(p1[14], p1[15]) & km};
    __builtin_amdgcn_s_setprio(1);
#pragma unroll
    for (int dh = 0; dh < 2; ++dh)
#pragma unroll
        for (int s = 0; s < 4; ++s) { const s16x4 lo = vtr(Vs + L.voff[dh][0] + 2048 * s), hi4 = vtr(Vs + L.voff[dh][1] + 2048 * s);
            const bf16x8 vf = (bf16x8){lo[0], lo[1], lo[2], lo[3], hi4[0], hi4[1], hi4[2], hi4[3]};
            o[dh] = __builtin_amdgcn_mfma_f32_32x32x16_bf16(vf, __builtin_bit_cast(bf16x8, pf[s]), o[dh], 0, 0, 0); }
    __builtin_amdgcn_s_setprio(0);
}
__device__ __forceinline__ void softmax2_pv(f32x16& a0, f32x16& a1, f32x16& b0, f32x16& b1, const LAS unsigned char* VsA, const LAS unsigned char* VsB, f32x16 (&o)[2], float& m, float& l, f32x16& cini,
                                            bool rowokA, bool rowokB, const LaneGeo& L) {
    float xa = max3f(a0[0], a0[1], a1[0]), xb = max3f(b0[0], b0[1], b1[0]);
#pragma unroll
    for (int r = 1; r < 15; r += 2) { xa = max3f(xa, a0[r + 1], a0[r + 2]); xa = max3f(xa, a1[r], a1[r + 1]); xb = max3f(xb, b0[r + 1], b0[r + 2]); xb = max3f(xb, b1[r], b1[r + 1]); }
    xa = __builtin_fmaxf(xa, a1[15]); xb = __builtin_fmaxf(xb, b1[15]);
    const float mxa = xhalf_max(xa), mxb = xhalf_max(xb);
    const float mx = __builtin_fmaxf(rowokA ? mxa : -INFINITY, rowokB ? mxb : -INFINITY);
    const bool grow = (mx > THR) || (l == 0.f && mx > MASK_TEST);
    if (__builtin_expect(__any(grow), 0)) {
        const float dl = grow ? mx : 0.f; m += dl; const float f = __builtin_amdgcn_exp2f(-dl); l *= f;
#pragma unroll
        for (int r = 0; r < 16; ++r) { a0[r] -= dl; a1[r] -= dl; b0[r] -= dl; b1[r] -= dl; o[0][r] *= f; o[1][r] *= f; cini[r] -= dl; }
    }
    float ra0 = 0.f, ra1 = 0.f, rb0 = 0.f, rb1 = 0.f;
#pragma unroll
    for (int r = 0; r < 16; ++r) { a0[r] = __builtin_amdgcn_exp2f(a0[r]); a1[r] = __builtin_amdgcn_exp2f(a1[r]); b0[r] = __builtin_amdgcn_exp2f(b0[r]); b1[r] = __builtin_amdgcn_exp2f(b1[r]);
        ra0 += a0[r]; ra0 += a1[r]; ra1 += b0[r]; ra1 += b1[r]; }
    const float rsa = xhalf_sum(ra0), rsb = xhalf_sum(ra1);
    l += (rowokA ? rsa : 0.f) + (rowokB ? rsb : 0.f);
    const unsigned ka = rowokA ? 0xffffffffu : 0u, kb = rowokB ? 0xffffffffu : 0u;
    v4u pa[4], pb[4];
    pa[0] = (v4u){cvtpk(a0[0], a0[1]) & ka, cvtpk(a0[2], a0[3]) & ka, cvtpk(a0[4], a0[5]) & ka, cvtpk(a0[6], a0[7]) & ka};
    pa[1] = (v4u){cvtpk(a0[8], a0[9]) & ka, cvtpk(a0[10], a0[11]) & ka, cvtpk(a0[12], a0[13]) & ka, cvtpk(a0[14], a0[15]) & ka};
    pa[2] = (v4u){cvtpk(a1[0], a1[1]) & ka, cvtpk(a1[2], a1[3]) & ka, cvtpk(a1[4], a1[5]) & ka, cvtpk(a1[6], a1[7]) & ka};
    pa[3] = (v4u){cvtpk(a1[8], a1[9]) & ka, cvtpk(a1[10], a1[11]) & ka, cvtpk(a1[12], a1[13]) & ka, cvtpk(a1[14], a1[15]) & ka};
    pb[0] = (v4u){cvtpk(b0[0], b0[1]) & kb, cvtpk(b0[2], b0[3]) & kb, cvtpk(b0[4], b0[5]) & kb, cvtpk(b0[6], b0[7]) & kb};
    pb[1] = (v4u){cvtpk(b0[8], b0[9]) & kb, cvtpk(b0[10], b0[11]) & kb, cvtpk(b0[12], b0[13]) & kb, cvtpk(b0[14], b0[15]) & kb};
    pb[2] = (v4u){cvtpk(b1[0], b1[1]) & kb, cvtpk(b1[2], b1[3]) & kb, cvtpk(b1[4], b1[5]) & kb, cvtpk(b1[6], b1[7]) & kb};
    pb[3] = (v4u){cvtpk(b1[8], b1[9]) & kb, cvtpk(b1[10], b1[11]) & kb, cvtpk(b1[12], b1[13]) & kb, cvtpk(b1[14], b1[15]) & kb};
    __builtin_amdgcn_s_setprio(1);
#pragma unroll
    for (int dh = 0; dh < 2; ++dh) {
#pragma unroll
        for (int s = 0; s < 4; ++s) { const s16x4 lo = vtr(VsA + L.voff[dh][0] + 2048 * s), hi4 = vtr(VsA + L.voff[dh][1] + 2048 * s);
            const bf16x8 vf = (bf16x8){lo[0], lo[1], lo[2], lo[3], hi4[0], hi4[1], hi4[2], hi4[3]};
            o[dh] = __builtin_amdgcn_mfma_f32_32x32x16_bf16(vf, __builtin_bit_cast(bf16x8, pa[s]), o[dh], 0, 0, 0); }
#pragma unroll
        for (int s = 0; s < 4; ++s) { const s16x4 lo = vtr(VsB + L.voff[dh][0] + 2048 * s), hi4 = vtr(VsB + L.voff[dh][1] + 2048 * s);
            const bf16x8 vf = (bf16x8){lo[0], lo[1], lo[2], lo[3], hi4[0], hi4[1], hi4[2], hi4[3]};
            o[dh] = __builtin_amdgcn_mfma_f32_32x32x16_bf16(vf, __builtin_bit_cast(bf16x8, pb[s]), o[dh], 0, 0, 0); } }
    __builtin_amdgcn_s_setprio(0);
}
__device__ __forceinline__ void store_o(bf16* orow, const f32x16 (&o)[2], int hi) {
#pragma unroll
    for (int dh = 0; dh < 2; ++dh)
#pragma unroll
        for (int a = 0; a < 4; ++a) { u32x2 w; w.x = cvtpk(o[dh][4 * a], o[dh][4 * a + 1]); w.y = cvtpk(o[dh][4 * a + 2], o[dh][4 * a + 3]);
            *(GAS u32x2*)(orow + 32 * dh + 8 * a + 4 * hi) = w; }
}
template <bool FIRST> __device__ __forceinline__ void out_branch(bf16* orow, const f32x16 (&o)[2], float sc, int hi) {
#pragma unroll
    for (int dh = 0; dh < 2; ++dh)
#pragma unroll
        for (int a = 0; a < 4; ++a) { GAS u32x2* p = (GAS u32x2*)(orow + 32 * dh + 8 * a + 4 * hi); float v0 = sc * o[dh][4 * a], v1 = sc * o[dh][4 * a + 1], v2 = sc * o[dh][4 * a + 2], v3 = sc * o[dh][4 * a + 3];
            if (!FIRST) { const u32x2 w = *p; v0 += __uint_as_float(w.x << 16); v1 += __uint_as_float(w.x & 0xffff0000u); v2 += __uint_as_float(w.y << 16); v3 += __uint_as_float(w.y & 0xffff0000u); }
            u32x2 w2; w2.x = cvtpk(v0, v1); w2.y = cvtpk(v2, v3); *p = w2; }
}
__device__ __forceinline__ void acc_branch(unsigned (&oacc)[2][8], const f32x16 (&o)[2], float sc) {
#pragma unroll
    for (int dh = 0; dh < 2; ++dh)
#pragma unroll
        for (int i = 0; i < 8; ++i) { const float lo = __uint_as_float(oacc[dh][i] << 16) + sc * o[dh][2 * i], hi2 = __uint_as_float(oacc[dh][i] & 0xffff0000u) + sc * o[dh][2 * i + 1]; oacc[dh][i] = cvtpk(lo, hi2); }
}
__device__ __forceinline__ void store_o_pk(bf16* orow, const unsigned (&oacc)[2][8], int hi) {
#pragma unroll
    for (int dh = 0; dh < 2; ++dh)
#pragma unroll
        for (int a = 0; a < 4; ++a) { u32x2 w; w.x = oacc[dh][2 * a]; w.y = oacc[dh][2 * a + 1]; *(GAS u32x2*)(orow + 32 * dh + 8 * a + 4 * hi) = w; }
}
__device__ __forceinline__ LAS v4u* oa_ptr(LAS unsigned char* lds, int wid, int lane, int k) { return (LAS v4u*)(lds + (k < 2 ? L_P4 : L_P3) + wid * 2048 + (k & 1) * 1024 + lane * 16); }
template <int MODE>
__device__ __forceinline__ void oa_branch(LAS unsigned char* lds, int wid, int lane, const f32x16 (&o)[2], float sc, bf16* orow, int hi) {
#pragma unroll
    for (int k = 0; k < 4; ++k) { const int dh = k >> 1, e0 = 8 * (k & 1); float v[8];
#pragma unroll
        for (int i = 0; i < 8; ++i) v[i] = sc * o[dh][e0 + i];
        if (MODE != 0) { const v4u w = *oa_ptr(lds, wid, lane, k);
#pragma unroll
            for (int i = 0; i < 4; ++i) { v[2 * i] += __uint_as_float(w[i] << 16); v[2 * i + 1] += __uint_as_float(w[i] & 0xffff0000u); } }
        v4u r; r.x = cvtpk(v[0], v[1]); r.y = cvtpk(v[2], v[3]); r.z = cvtpk(v[4], v[5]); r.w = cvtpk(v[6], v[7]);
        if (MODE != 2) *oa_ptr(lds, wid, lane, k) = r;
        else { *(GAS u32x2*)(orow + 32 * dh + 8 * (2 * (k & 1)) + 4 * hi) = (u32x2){r.x, r.y}; *(GAS u32x2*)(orow + 32 * dh + 8 * (2 * (k & 1) + 1) + 4 * hi) = (u32x2){r.z, r.w}; } }
}
__device__ __forceinline__ void build_tb(LAS unsigned short* tb, const float* rel_bias, int g, int wlim, int tid) {
    for (int i = tid; i < 4 * TSZ; i += 512) { const int h = i & 3, d = (i >> 2) - 64;
        unsigned short v = TB_MASK;
        if (d >= 0 && d < wlim) { const float x = (rel_bias[(int)BUCKET[d > 128 ? 128 : d] * NH + g * 4 + h] - rel_bias[31 * NH + g * 4 + h]) * LOG2E; v = (unsigned short)f2bf(x); }
        tb[i] = v; }
}
__device__ __forceinline__ void build_tb_global(unsigned short* tb, const float* rel_bias, int g, int wlim, int tid) {
    for (int i = tid; i < 4 * TSZ; i += 512) { const int h = i & 3, d = (i >> 2) - 64;
        unsigned short v = TB_MASK;
        if (d >= 0 && d < wlim) { const float x = (rel_bias[(int)BUCKET[d > 128 ? 128 : d] * NH + g * 4 + h] - rel_bias[31 * NH + g * 4 + h]) * LOG2E; v = (unsigned short)f2bf(x); }
        tb[i] = v; }
}
__device__ __forceinline__ void make_idf(bf16x8 (&idf)[2], int r32, int hi) {
    const int s_l = r32 >> 4, hh_l = (r32 >> 3) & 1, j_l = r32 & 7; const unsigned one = 0x3F80u << (16 * (j_l & 1));
#pragma unroll
    for (int s = 0; s < 2; ++s) { v4u w;
#pragma unroll
        for (int k = 0; k < 4; ++k) w[k] = (s == s_l && hi == hh_l && (j_l >> 1) == k) ? one : 0u;
        idf[s] = __builtin_bit_cast(bf16x8, w); }
}
__device__ __forceinline__ bf16x8 tb_frag(const LAS unsigned char* p) { const u32x2 a = *(const LAS u32x2*)p, b = *(const LAS u32x2*)(p + 8); return __builtin_bit_cast(bf16x8, (v4u){a.x, a.y, b.x, b.y}); }
__device__ __forceinline__ void bias_mma_u(f32x16& p0, f32x16& p1, const LAS unsigned char* tb, int D0, const LaneGeo& L, const bf16x8 (&idf)[2]) {
    const LAS unsigned char* bp = tb + (D0 + 8 * L.wid + 2 * L.hi - L.r32 + 32) * 8;
#pragma unroll
    for (int s = 0; s < 2; ++s) { const bf16x8 a1 = tb_frag(bp + 32 * s), a0 = tb_frag(bp + 256 + 32 * s);
        p0 = __builtin_amdgcn_mfma_f32_32x32x16_bf16(a0, idf[s], p0, 0, 0, 0); p1 = __builtin_amdgcn_mfma_f32_32x32x16_bf16(a1, idf[s], p1, 0, 0, 0); }
}
__device__ __forceinline__ void bias_mma_c(f32x16& p0, f32x16& p1, const LAS unsigned char* tb, int Dc, const LaneGeo& L, const bf16x8 (&idf)[2]) {
    const int db = Dc + 8 * L.wid + 2 * L.hi - 16 * L.r32;
#pragma unroll
    for (int s = 0; s < 2; ++s) { const int d0 = med3i(db + 4 * s, -2, 128), d1 = med3i(db + 4 * s - 512, -2, 128);
        const bf16x8 a0 = tb_frag(tb + (d0 + 64) * 8), a1 = tb_frag(tb + (d1 + 64) * 8);
        p0 = __builtin_amdgcn_mfma_f32_32x32x16_bf16(a0, idf[s], p0, 0, 0, 0); p1 = __builtin_amdgcn_mfma_f32_32x32x16_bf16(a1, idf[s], p1, 0, 0, 0); }
}

__device__ __forceinline__ float nsa_topk_val(const LAS float* P4, const LAS float* P3, int q, int j, int qb) {
    float v = P4[q * 64 + j] + (j > 0 ? P3[q * 64 + j - 1] : 0.f);
    const int code = (j == 0) ? 3 : (j == qb) ? 2 : (j == qb - 1) ? 1 : (j > qb) ? -(1024 + j) : 0;
    return code > 0 ? (float)code * 1e9f : (code < 0 ? (float)code * 1048576.0f : v);
}
__device__ __forceinline__ unsigned long long nsa_topk_exact(float v, int j) {
    int cnt = 0;
    for (int k = 0; k < 64; ++k) { const float vk = __int_as_float(__builtin_amdgcn_readlane(__float_as_int(v), k)); cnt += ((vk > v) || (vk == v && k < j)) ? 1 : 0; }
    return __ballot(cnt < 16);
}
__device__ __forceinline__ void nsa_topk(const LAS float* P4, const LAS float* P3, LAS unsigned long long* selm, int wid, int lane, int qb) {
    asm volatile("s_waitcnt lgkmcnt(0)" ::: "memory");
#pragma unroll 1
    for (int i = 0; i < 8; i += 2) { const int q = 8 * wid + i; const int j = lane;
        const float v0 = nsa_topk_val(P4, P3, q, j, qb), v1 = nsa_topk_val(P4, P3, q + 1, j, qb);
        float w0 = v0, w1 = v1; int c0 = 0, c1 = 0;
#pragma unroll
        for (int r = 1; r < 64; ++r) {
            w0 = __int_as_float(__builtin_amdgcn_mov_dpp(__float_as_int(w0), 0x13C, 0xF, 0xF, false));
            w1 = __int_as_float(__builtin_amdgcn_mov_dpp(__float_as_int(w1), 0x13C, 0xF, 0xF, false));
            c0 += (w0 > v0) ? 1 : 0; c1 += (w1 > v1) ? 1 : 0; }
        unsigned long long mk0 = __ballot(c0 < 16), mk1 = __ballot(c1 < 16);
        if (__builtin_popcountll(mk0) != 16) mk0 = nsa_topk_exact(v0, j);
        if (__builtin_popcountll(mk1) != 16) mk1 = nsa_topk_exact(v1, j);
        if (lane == 0) { selm[q] = mk0; selm[q + 1] = mk1; } }
    asm volatile("s_waitcnt lgkmcnt(0)" ::: "memory");
}

struct NsaArgs { const bf16* Q; const bf16* KV; const bf16* kcmp; const bf16* vcmp; const float* gates; const float* rel_bias; bf16* O; unsigned* work; const unsigned char* tbl; };
__device__ __forceinline__ void nsa_tile_src(const NsaArgs& A, int bg, int qb, int ntc, int nB, int j0, int ntot, int n, const bf16*& gK, const bf16*& gV) {
    const size_t base = (size_t)bg * SEQ * 64;
    if (n >= ntot) n = 0;
    if (n < ntc + nB) { const int ct = n < ntc ? n : n - ntc; gK = A.kcmp + (size_t)bg * 256 * 64 + (size_t)ct * 4096; gV = A.vcmp + (size_t)bg * 256 * 64 + (size_t)ct * 4096; return; }
    n -= ntc + nB;
    if (n <= qb) { gK = A.KV + 2 * KVT + base + (size_t)n * 4096; gV = A.KV + 3 * KVT + base + (size_t)n * 4096; return; }
    n -= qb + 1;
    gK = A.KV + 4 * KVT + base + (size_t)(j0 + n) * 4096; gV = A.KV + 5 * KVT + base + (size_t)(j0 + n) * 4096;
}
template <int VAR> __device__ __forceinline__ void nsa_unit(const NsaArgs& A, LAS unsigned char* lds, unsigned lds0, int b, int g, int qb, int tid) {
    asm volatile("" : "+v"(tid));
    LaneGeo L; L.init(tid);
    const int lane = L.lane, wid = L.wid, r32 = L.r32, hi = L.hi;
    const int ql = 8 * wid + (r32 >> 2), hj = r32 & 3, s0 = 64 * qb, tq = s0 + ql, bg = b * 4 + g;
    const LAS unsigned char* tb = lds + L_TB;
    LAS float* P4 = (LAS float*)(lds + L_P4); LAS float* P3 = (LAS float*)(lds + L_P3);
    LAS unsigned long long* selm = (LAS unsigned long long*)(lds + L_SEL);
    const int ncmp = 4 * qb + 3, ntc = (ncmp + 63) >> 6;
    const int nB = qb >= 16 ? ntc : 0;
    const int j0 = qb >= 8 ? qb - 8 : 0, nwin = qb - j0 + 1, ntot = ntc + nB + (qb + 1) + nwin;
    const bf16 *gK, *gV;
    if (wid < TSZ * 8 / 1024) glds16(A.tbl + g * (TSZ * 8) + wid * 1024 + lane * 16, (unsigned)__builtin_amdgcn_readfirstlane((int)(lds0 + L_TB + wid * 1024)));
#pragma unroll
    for (int n = 0; n < 4; ++n) { nsa_tile_src(A, bg, qb, ntc, nB, j0, ntot, n, gK, gV); dma_tile(L, gK, gV, lds0, n); }
    bf16x8 idf[2]; make_idf(idf, r32, hi);
    for (int i = lane; i < 512; i += 64) { P4[(8 * wid) * 64 + i] = 0.f; P3[(8 * wid) * 64 + i] = 0.f; }
    const size_t trow = (size_t)b * SEQ + tq;
    bf16x8 qr[4];
    { const bf16* qp = A.Q + trow * DM + g * 256 + hj * 64 + hi * 8;
#pragma unroll
      for (int d0 = 0; d0 < 4; ++d0) qr[d0] = *(const GAS bf16x8*)(qp + d0 * 16); }
    f32x16 o[2], p0, p1; float m = 0.f, l = 0.f, linv_c = 0.f;
    o[0] = (f32x16){}; o[1] = (f32x16){};
    unsigned mlo = qb >= 31 ? 0xffffffffu : ((2u << qb) - 1u), mhi = qb >= 32 ? (qb >= 63 ? 0xffffffffu : ((2u << (qb - 32)) - 1u)) : 0u;
    float bias_far = A.rel_bias[31 * NH + g * 4 + hj] * LOG2E; f32x16 cini;
    float gt0p, gt1p, gt2p; { const float* gp = A.gates + ((size_t)b * SEQ + tq) * 48 + g * 4 + hj; gt0p = gp[0] * DBG_S0; gt1p = gp[16] * DBG_S1; gt2p = gp[32] * DBG_S2; }
    asm volatile("" : "+v"(qr[0]), "+v"(qr[1]), "+v"(qr[2]), "+v"(qr[3]), "+v"(gt0p), "+v"(gt1p), "+v"(gt2p), "+v"(bias_far));
#pragma unroll
    for (int r = 0; r < 16; ++r) cini[r] = bias_far;
#define NSA_OROW (A.O + ((size_t)b * SEQ + tq) * DM + g * 256 + hj * 64)
#define NSA_GATE(br) (A.gates[((size_t)b * SEQ + tq) * 48 + (br) * 16 + g * 4 + hj])
    const int nsteps = (ntot + 1) >> 1;
    for (int st = 0; st < nsteps; ++st) {
        ATT_WAIT_BAR(4);
#pragma unroll
        for (int sub = 0; sub < 2; ++sub) { nsa_tile_src(A, bg, qb, ntc, nB, j0, ntot, 2 * st + 4 + sub, gK, gV); dma_tile(L, gK, gV, lds0, ((st + 2) % 3) * 2 + sub); }
        { const int eB_ = ntc + nB, jA = 2 * st - eB_;
          if (2 * st >= eB_ && jA + 1 <= qb - 3) {
              const bool rsA = ((jA < 32 ? (mlo >> jA) : (mhi >> (jA - 32))) & 1u) != 0u, rsB = ((jA + 1 < 32 ? (mlo >> (jA + 1)) : (mhi >> (jA + 1 - 32))) & 1u) != 0u;
              if (__any(rsA) && __any(rsB)) {
                  const LAS unsigned char* KsA = lds + L_RING + ((st % 3) * 2) * SLOT_B; const LAS unsigned char* KsB = KsA + SLOT_B;
                  f32x16 q0, q1;
                  qk_tile(p0, p1, KsA, qr, L, cini); qk_tile(q0, q1, KsB, qr, L, cini);
                  softmax2_pv(p0, p1, q0, q1, KsA + 8192, KsB + 8192, o, m, l, cini, rsA, rsB, L);
                  continue; } } }
#define NSA_ROWSEL(j_) ((((j_) < 32 ? (mlo >> (j_)) : (mhi >> ((j_) - 32))) & 1u) != 0u)
#define NSA_SCORES(P0, P1, nn, Ks_) do { const int n_ = (nn); qk_tile(P0, P1, Ks_, qr, L, cini); \
        if (n_ < ntc) { if ((s0 - 31 - 1024 * n_ - 16 * 63) < 128) bias_mma_c(P0, P1, tb, s0 - 31 - 1024 * n_, L, idf); } \
        else if (n_ < eS2_) { const int j_ = n_ - eB2_; if (j_ > qb - 3) bias_mma_u(P0, P1, tb, 64 * (qb - j_), L, idf); } \
        else { const int dj_ = qb - (j0 + (n_ - eS2_)); if (dj_ < 3 || dj_ > 7) bias_mma_u(P0, P1, tb, 64 * dj_, L, idf); } } while (0)
        { const int eB2_ = ntc + nB, eS2_ = eB2_ + qb + 1, n0 = 2 * st, n1 = n0 + 1;
          const bool inA = n1 < ntc, inS = n0 >= eB2_ && n1 < eS2_, inW = n0 >= eS2_ && n1 < ntot;
          if (inA || inS || inW) {
              bool rsA = true, rsB = true;
              if (inS) { rsA = NSA_ROWSEL(n0 - eB2_); rsB = NSA_ROWSEL(n1 - eB2_); }
              if (__any(rsA) && __any(rsB)) {
                  const LAS unsigned char* KsA = lds + L_RING + ((st % 3) * 2) * SLOT_B; const LAS unsigned char* KsB = KsA + SLOT_B;
                  f32x16 q0, q1;
                  NSA_SCORES(p0, p1, n0, KsA); NSA_SCORES(q0, q1, n1, KsB);
                  softmax2_pv(p0, p1, q0, q1, KsA + 8192, KsB + 8192, o, m, l, cini, rsA, rsB, L);
                  if (n1 == ntc - 1) { linv_c = l > 0.f ? 1.0f / l : 0.f; l = 0.f;
                      if (nB == 0) { oa_branch<0>(lds, wid, lane, o, gt0p * linv_c, nullptr, hi); m = 0.f;
#pragma unroll
                          for (int r = 0; r < 16; ++r) { o[0][r] = 0.f; o[1][r] = 0.f; cini[r] = bias_far; } } }
                  if (n1 == eS2_ - 1) { oa_branch<1>(lds, wid, lane, o, gt1p * (l > 0.f ? 1.0f / l : 0.f), nullptr, hi);
#pragma unroll
                      for (int r = 0; r < 16; ++r) { o[0][r] = 0.f; o[1][r] = 0.f; cini[r] = bias_far; }
                      m = 0.f; l = 0.f; }
                  continue; } } }
#undef NSA_SCORES
#undef NSA_ROWSEL
#pragma unroll 1
      for (int sub = 0; sub < 2; ++sub) {
        const int n = 2 * st + sub; if (n >= ntot) break;
        const LAS unsigned char* Ks = lds + L_RING + ((st % 3) * 2 + sub) * SLOT_B; const LAS unsigned char* Vs = Ks + 8192;
        if (n < ntc + nB) {
            const bool passB = n >= ntc; const int ct = passB ? n - ntc : n;
            const bool far = (s0 - 31 - 1024 * ct - 16 * 63) >= 128;
            qk_tile(p0, p1, Ks, qr, L, cini);
            if (!far) bias_mma_c(p0, p1, tb, s0 - 31 - 1024 * ct, L, idf);
            if (!passB) {
                softmax_pv(p0, p1, Vs, o, m, l, cini, true, L);
                if (n == ntc - 1) { linv_c = l > 0.f ? 1.0f / l : 0.f; l = 0.f;
                    if (nB == 0) { oa_branch<0>(lds, wid, lane, o, gt0p * linv_c, nullptr, hi); m = 0.f;
#pragma unroll
                        for (int r = 0; r < 16; ++r) { o[0][r] = 0.f; o[1][r] = 0.f; cini[r] = bias_far; } } }
            } else {
#pragma unroll
                for (int r = 0; r < 16; ++r) { p0[r] = __builtin_amdgcn_exp2f(p0[r]) * linv_c; p1[r] = __builtin_amdgcn_exp2f(p1[r]) * linv_c; }
#pragma unroll
                for (int pp = 0; pp < 2; ++pp)
#pragma unroll
                    for (int a = 0; a < 4; ++a) { float s3 = pp ? p1[4 * a + 3] : p0[4 * a + 3];
                        float s4 = pp ? (p1[4 * a] + p1[4 * a + 1]) + (p1[4 * a + 2] + p1[4 * a + 3]) : (p0[4 * a] + p0[4 * a + 1]) + (p0[4 * a + 2] + p0[4 * a + 3]);
                        s4 = quad_sum(s4); s3 = quad_sum(s3);
                        if (hj == 0) { const int j = 16 * ct + 8 * pp + 2 * a + hi; P4[ql * 64 + j] = s4; P3[ql * 64 + j] = s3; } }
                if (n == ntc + nB - 1) {
                    nsa_topk(P4, P3, selm, wid, lane, qb);
                    const unsigned long long mm = selm[ql]; mlo = (unsigned)mm; mhi = (unsigned)(mm >> 32);
                    oa_branch<0>(lds, wid, lane, o, gt0p * linv_c, nullptr, hi);
                    m = 0.f;
#pragma unroll
                    for (int r = 0; r < 16; ++r) { o[0][r] = 0.f; o[1][r] = 0.f; cini[r] = bias_far; }
                }
            }
        } else if (n < ntc + nB + qb + 1) {
            const int j = n - (ntc + nB);
            const bool rowsel = ((j < 32 ? (mlo >> j) : (mhi >> (j - 32))) & 1u) != 0u;
            if (__any(rowsel)) {
                qk_tile(p0, p1, Ks, qr, L, cini);
                if (j > qb - 3) bias_mma_u(p0, p1, tb, 64 * (qb - j), L, idf);
                softmax_pv(p0, p1, Vs, o, m, l, cini, rowsel, L);
            }
            if (j == qb) { oa_branch<1>(lds, wid, lane, o, gt1p * (l > 0.f ? 1.0f / l : 0.f), nullptr, hi);
#pragma unroll
                for (int r = 0; r < 16; ++r) { o[0][r] = 0.f; o[1][r] = 0.f; cini[r] = bias_far; }
                m = 0.f; l = 0.f; }
        } else {
            const int j = j0 + (n - (ntc + nB) - qb - 1); const int dj = qb - j;
            qk_tile(p0, p1, Ks, qr, L, cini);
            if (dj < 3 || dj > 7) bias_mma_u(p0, p1, tb, 64 * dj, L, idf);
            softmax_pv(p0, p1, Vs, o, m, l, cini, true, L);
        }
      }
    }
    oa_branch<2>(lds, wid, lane, o, gt2p * (l > 0.f ? 1.0f / l : 0.f), NSA_OROW, hi);
#undef NSA_OROW
#undef NSA_GATE
    ATT_WAIT_BAR(0);
}
template <int VAR> __device__ __forceinline__ void nsa_phase(const NsaArgs& A, LAS unsigned char* lds, unsigned lds0, int tid) {
    LAS int* nextu = (LAS int*)(lds + L_NEXT);
    int unext = 0;
    if (tid == 0) unext = (int)__hip_atomic_fetch_add(A.work, 1u, __ATOMIC_RELAXED, __HIP_MEMORY_SCOPE_AGENT);
    for (;;) {
        if (tid == 0) nextu[0] = unext;
        __syncthreads();
        const int u = nextu[0];
        __syncthreads();
        if (u >= NB * NG * 64) break;
        if (tid == 0) unext = (int)__hip_atomic_fetch_add(A.work, 1u, __ATOMIC_RELAXED, __HIP_MEMORY_SCOPE_AGENT);
        const int qb = 63 - (u >> 5), bg = u & 31;
        nsa_unit<VAR>(A, lds, lds0, bg >> 2, bg & 3, qb, tid);
    }
}

struct SwaArgs { const bf16* Q; const bf16* KV; const float* sinks; const float* rel_bias; bf16* O; };
constexpr int LS_QB = 4 * SLOT_B, LS_TAB = LS_QB + 2 * 32768, LS_END = LS_TAB + TSZ * 8;
static_assert(LS_END <= RING_BYTES, "SWA LDS");
__device__ __forceinline__ void swa_phase(const SwaArgs& A, LAS unsigned char* lds, unsigned lds0, int blk, int G, int tid) {
    LaneGeo L; L.init(tid);
    const int lane = L.lane, wid = L.wid, r32 = L.r32, hi = L.hi;
    const int hj = r32 & 3;
    const int nU = (NB * NG * 64 - blk + G - 1) / G, ntot = 3 * nU;
    const int g = (blk >> 6) & 3;
    const LAS unsigned char* tb = lds + LS_TAB;
    bf16x8 idf[2]; make_idf(idf, r32, hi);
#define SWA_TILE(tt, gK_, gV_, val_) do { int t_ = (tt); if (t_ >= ntot) t_ = ntot - 1; const int u_ = blk + G * (t_ / 3), qb_ = u_ & 63, bg_ = u_ >> 6; int j_ = qb_ - 2 + (t_ % 3); val_ = j_ >= 0; if (j_ < 0) j_ = 0; \
        gK_ = A.KV + (size_t)bg_ * SEQ * 64 + (size_t)j_ * 4096; gV_ = A.KV + KVT + (size_t)bg_ * SEQ * 64 + (size_t)j_ * 4096; } while (0)
#define SWA_QDMA(ii) do { int i_ = (ii); if (i_ >= nU) i_ = nU - 1; const int u_ = blk + G * i_, qb_ = u_ & 63, b_ = u_ >> 8; \
        _Pragma("unroll") for (int pc = 0; pc < 4; ++pc) { const int ql_ = 8 * wid + 2 * pc + (lane >> 5); \
            const char* src_ = (const char*)(A.Q + ((size_t)b_ * SEQ + 64 * qb_ + ql_) * DM + g * 256) + (lane & 31) * 16; \
            glds16(src_, (unsigned)__builtin_amdgcn_readfirstlane((int)(lds0 + LS_QB + ((ii) & 1) * 32768 + (4 * wid + pc) * 1024))); } } while (0)
    const bf16 *gK, *gV; bool val;
    SWA_QDMA(0);
#pragma unroll
    for (int t = 0; t < 3; ++t) { SWA_TILE(t, gK, gV, val); dma_tile(L, gK, gV, lds0, t); }
    build_tb((LAS unsigned short*)(lds + LS_TAB), A.rel_bias, g, 128, tid);
    const float sink = A.sinks[g * 4 + hj] * LOG2E;
    float sinkp = sink, bias_far = A.rel_bias[31 * NH + g * 4 + hj] * LOG2E; asm volatile("" : "+v"(sinkp), "+v"(bias_far));
    f32x16 cini = (f32x16){};
    bf16x8 qr[4]; f32x16 o[2], p0, p1; float m = 0.f, l = 1.f; int tq = 0;
    o[0] = (f32x16){}; o[1] = (f32x16){};
    for (int t = 0; t < ntot; ++t) {
        const int i = t / 3, k = t - 3 * i;
        if (k == 0) ATT_WAIT_BAR(4); else ATT_WAIT_BAR(8);
        { SWA_TILE(t + 3, gK, gV, val); dma_tile(L, gK, gV, lds0, (t + 3) & 3); }
        const int u = blk + G * i, qb = u & 63, b = u >> 8;
        if (k == 0) {
            SWA_QDMA(i + 1);
            const LAS unsigned char* qb_l = lds + LS_QB + (i & 1) * 32768 + (8 * wid + (r32 >> 2)) * 512 + hj * 128 + hi * 16;
#pragma unroll
            for (int d0 = 0; d0 < 4; ++d0) qr[d0] = *(const LAS bf16x8*)(qb_l + d0 * 32);
            m = sinkp; l = 1.0f; o[0] = (f32x16){}; o[1] = (f32x16){};
#pragma unroll
            for (int r = 0; r < 16; ++r) cini[r] = bias_far - m;
            tq = 64 * qb + 8 * wid + (r32 >> 2);
        }
        const int j = qb - 2 + k;
        if (j >= 0) {
            const LAS unsigned char* Ks = lds + L_RING + (t & 3) * SLOT_B; const LAS unsigned char* Vs = Ks + 8192;
            qk_tile(p0, p1, Ks, qr, L, cini);
            bias_mma_u(p0, p1, tb, 64 * (qb - j), L, idf);
            softmax_pv(p0, p1, Vs, o, m, l, cini, true, L);
        }
        if (k == 2) {
            const float sc = DBG_SWA / l;
#pragma unroll
            for (int r = 0; r < 16; ++r) { o[0][r] *= sc; o[1][r] *= sc; }
            store_o(A.O + ((size_t)b * SEQ + tq) * DM + g * 256 + hj * 64, o, hi);
        }
    }
#undef SWA_TILE
#undef SWA_QDMA
    ATT_WAIT_BAR(0);
}
}

using pg8::Unit; using pg8::f32x4;
struct SchedPlain {
    pg8::GridOrder go; int arow_off;
    __device__ bool next(int i, Unit& u) const { u.e = 0; u.lt = 0; return go.tile(i, u.pm, u.pn); }
    __device__ int a_row(const Unit& u, int r) const { return arow_off + u.pm * 256 + r; }
    __device__ int b_row0(const Unit& u) const { return u.pn * 256; }
};
struct SchedCmp {
    pg8::GridOrder go;
    __device__ bool next(int i, Unit& u) const { u.e = 0; u.lt = 0; return go.tile(i, u.pm, u.pn); }
    __device__ int a_row(const Unit& u, int r) const { return u.pm * 256 + r; }
    __device__ int b_row0(const Unit& u) const { return (u.pm >= 32 ? 512 : 0) + u.pn * 256; }
};
struct SchedCmpGate {
    int G, c, cmp_rowoff, cmp_brow;
    __device__ bool next(int i, Unit& u) const { const long L = (long)i * G + c; if (L >= 256) return false; u.lt = 0;
        if (L < 128) { u.e = 0; u.pm = (int)(L >> 1); u.pn = (int)(L & 1); } else { u.e = 1; u.pm = (int)L - 128; u.pn = 0; } return true; }
    __device__ int a_row(const Unit& u, int r) const { return (u.e ? 0 : cmp_rowoff) + u.pm * 256 + r; }
    __device__ int b_row0(const Unit& u) const { return u.e ? 2560 : cmp_brow + (u.pm >= 32 ? 512 : 0) + u.pn * 256; }
};
struct SchedL1 {
    pg8::GridOrder go; int xb_rowoff;
    __device__ bool next(int i, Unit& u) const { u.e = 0; u.lt = 0; return go.tile(i, u.pm, u.pn); }
    __device__ int a_row(const Unit& u, int r) const { return (u.pn >= 4 ? xb_rowoff : 0) + u.pm * 256 + r; }
    __device__ int b_row0(const Unit& u) const { return u.pn * 256; }
};
template <int NPN, bool GATHER, int BROWS>
struct SchedMoe {
    const unsigned* list; int G, c, ioff, imax; volatile LAS unsigned* tab;
    __device__ __forceinline__ void init(const unsigned* cnt, const unsigned* list_, int G_, int c_, volatile LAS unsigned* tab_, int ioff_ = 0, int imax_ = 1 << 28) { list = list_; G = G_; c = c_; tab = tab_; ioff = ioff_; imax = imax_;
        if (threadIdx.x == 0) { unsigned base = 0u; for (int e = 0; e < NE; ++e) { const unsigned n = cnt[e]; tab[e] = n; tab[16 + e] = base; base += (n + 255u) >> 8; } tab[32] = base; }
        __syncthreads(); }
    __device__ __forceinline__ bool next(int i, Unit& u) const {
        if (i >= imax) return false;
        const long L = (long)(i + ioff) * G + c; const int mt = (int)(L / NPN); u.pn = (int)(L % NPN); u.pm = mt; u.e = 0; u.lt = 0;
        if (mt >= (int)tab[32]) return false;
#pragma unroll
        for (int e = 0; e < NE; ++e) { const int pe = (int)tab[16 + e]; if (mt >= pe) { u.e = e; u.lt = mt - pe; } }
        u.e = __builtin_amdgcn_readfirstlane(u.e); u.lt = __builtin_amdgcn_readfirstlane(u.lt);
        return true;
    }
    __device__ __forceinline__ int a_row(const Unit& u, int r) const {
        if (!GATHER) return u.pm * 256 + r;
        const int idx = u.lt * 256 + r; return idx < (int)tab[u.e] ? (int)(list[(size_t)u.e * NT + idx] >> 1) : 0;
    }
    __device__ __forceinline__ int b_row0(const Unit& u) const { return u.e * BROWS + u.pn * 256; }
};

template <int NPN, int BROWS>
struct SchedMoeLate {
    const unsigned* flag; int G, c, R; volatile LAS unsigned* tab;
    __device__ __forceinline__ void init(const unsigned* cnt, int G_, int c_, volatile LAS unsigned* tab_, const unsigned* flag_) { G = G_; c = c_; tab = tab_; flag = flag_;
        if (threadIdx.x == 0) { unsigned base = 0u; for (int e = 0; e < NE; ++e) { const unsigned n = cnt[e]; tab[e] = n; tab[16 + e] = base; base += (n + 255u) >> 8; } tab[32] = base; }
        __syncthreads();
        const int r = 2 * (int)tab[32] - 2 * G; R = r < 0 ? 0 : (r > G ? G : r); }
    __device__ __forceinline__ bool next(int i, Unit& u) const {
        const int E = G - R;
        long L;
        if (c >= R) L = i < 2 ? (long)i * E + (c - R) : 2L * E + (long)(i - 2) * G + c; else L = 2L * E + (long)i * G + c;
        const int mt = (int)(L / NPN); u.pn = (int)(L % NPN); u.pm = mt; u.e = 0; u.lt = 0;
        if (mt >= (int)tab[32]) return false;
#pragma unroll
        for (int e = 0; e < NE; ++e) { const int pe = (int)tab[16 + e]; if (mt >= pe) { u.e = e; u.lt = mt - pe; } }
        u.e = __builtin_amdgcn_readfirstlane(u.e); u.lt = __builtin_amdgcn_readfirstlane(u.lt);
        if (mt >= G && R > 0) {
            unsigned sp = 0u;
            while (__hip_atomic_load(flag, __ATOMIC_RELAXED, __HIP_MEMORY_SCOPE_AGENT) < (unsigned)R) { __builtin_amdgcn_s_sleep(2); if (++sp > (1u << 22)) break; }
            __builtin_amdgcn_fence(__ATOMIC_ACQUIRE, "agent");
            asm volatile("s_waitcnt vmcnt(0)" ::: "memory"); }
        return true;
    }
    __device__ __forceinline__ int a_row(const Unit& u, int r) const { return u.pm * 256 + r; }
    __device__ __forceinline__ int b_row0(const Unit& u) const { return u.e * BROWS + u.pn * 256; }
};

__device__ __forceinline__ v4u pack8(const f32x4& a, const f32x4& b, float s) {
    v4u w; w.x = pg8::cvt_pk_bf16(a[0] * s, a[1] * s); w.y = pg8::cvt_pk_bf16(a[2] * s, a[3] * s); w.z = pg8::cvt_pk_bf16(b[0] * s, b[1] * s); w.w = pg8::cvt_pk_bf16(b[2] * s, b[3] * s); return w; }
__device__ __forceinline__ bf16* kv_addr(bf16* KV, int ten, int m, int c) { const int b = m >> 12, s = m & 4095, g = c >> 6, d = c & 63; return KV + (size_t)ten * KVT + ((size_t)((b * 4 + g) * SEQ + s)) * 64 + d; }

struct EpiProj {
    static constexpr bool PERM = true;
    bf16* Q; bf16* KV; float* gates;
    __device__ __forceinline__ void operator()(const f32x4 (&acc)[2][2][4][2], const Unit& u, int wr, int wc, int fr, int fq) const {
#pragma unroll
        for (int ai = 0; ai < 2; ++ai)
#pragma unroll
            for (int m = 0; m < 4; ++m) { const int row = u.pm * 256 + ai * 128 + wr * 64 + m * 16 + fr;
#pragma unroll
                for (int bj = 0; bj < 2; ++bj) { const int ct = bj * 128 + wc * 32 + 8 * fq; const f32x4 v0 = acc[ai][bj][m][0], v1 = acc[ai][bj][m][1];
                    if (u.pn < 4) { *(GAS v4u*)(Q + (size_t)row * DM + u.pn * 256 + ct) = pack8(v0, v1, QSCALE); }
                    else if (u.pn < 10) { *(GAS v4u*)kv_addr(KV, u.pn - 4, row, ct) = pack8(v0, v1, 1.0f); }
                    else if (ct < 48) { float* gp = gates + (size_t)row * 48 + ct;
                        *(GAS f32x4*)gp = (f32x4){sigmoidf_(v0[0]), sigmoidf_(v0[1]), sigmoidf_(v0[2]), sigmoidf_(v0[3])};
                        *(GAS f32x4*)(gp + 4) = (f32x4){sigmoidf_(v1[0]), sigmoidf_(v1[1]), sigmoidf_(v1[2]), sigmoidf_(v1[3])}; } } }
    }
};
struct EpiL1 {
    static constexpr bool PERM = true;
    bf16* Q; bf16* KV;
    __device__ __forceinline__ void operator()(const f32x4 (&acc)[2][2][4][2], const Unit& u, int wr, int wc, int fr, int fq) const {
#pragma unroll
        for (int ai = 0; ai < 2; ++ai)
#pragma unroll
            for (int m = 0; m < 4; ++m) { const int row = u.pm * 256 + ai * 128 + wr * 64 + m * 16 + fr;
#pragma unroll
                for (int bj = 0; bj < 2; ++bj) { const int ct = bj * 128 + wc * 32 + 8 * fq; const f32x4 v0 = acc[ai][bj][m][0], v1 = acc[ai][bj][m][1];
                    if (u.pn < 4) { *(GAS v4u*)(Q + (size_t)row * DM + u.pn * 256 + ct) = pack8(v0, v1, QSCALE); }
                    else { *(GAS v4u*)kv_addr(KV, u.pn - 4, row, ct) = pack8(v0, v1, 1.0f); } } }
    }
};
struct EpiF32 {
    static constexpr bool PERM = false;
    float* O; int ldc;
    __device__ __forceinline__ void operator()(const f32x4 (&acc)[2][2][4][2], const Unit& u, int wr, int wc, int fr, int fq) const {
#pragma unroll
        for (int ai = 0; ai < 2; ++ai)
#pragma unroll
            for (int m = 0; m < 4; ++m) { float* rp = O + (size_t)(u.pm * 256 + ai * 128 + wr * 64 + m * 16 + fr) * ldc + u.pn * 256 + wc * 32 + 4 * fq;
#pragma unroll
                for (int bj = 0; bj < 2; ++bj)
#pragma unroll
                    for (int n = 0; n < 2; ++n) *(GAS f32x4*)(rp + bj * 128 + n * 16) = acc[ai][bj][m][n]; }
    }
};
struct EpiCmpGate {
    static constexpr bool PERM = false;
    float* UL; float* gates;
    __device__ __forceinline__ void operator()(const f32x4 (&acc)[2][2][4][2], const Unit& u, int wr, int wc, int fr, int fq) const {
#pragma unroll
        for (int ai = 0; ai < 2; ++ai)
#pragma unroll
            for (int m = 0; m < 4; ++m) { const int row = u.pm * 256 + ai * 128 + wr * 64 + m * 16 + fr;
#pragma unroll
                for (int bj = 0; bj < 2; ++bj)
#pragma unroll
                    for (int n = 0; n < 2; ++n) { const int c = bj * 128 + wc * 32 + n * 16 + 4 * fq; const f32x4 v = acc[ai][bj][m][n];
                        if (u.e == 0) *(GAS f32x4*)(UL + (size_t)row * 512 + u.pn * 256 + c) = v;
                        else if (c < 48) *(GAS f32x4*)(gates + (size_t)row * 48 + c) = (f32x4){sigmoidf_(v[0]), sigmoidf_(v[1]), sigmoidf_(v[2]), sigmoidf_(v[3])}; } }
    }
};
struct EpiBf16 {
    static constexpr bool PERM = true;
    bf16* O; int ldc;
    __device__ __forceinline__ void operator()(const f32x4 (&acc)[2][2][4][2], const Unit& u, int wr, int wc, int fr, int fq) const {
#pragma unroll
        for (int ai = 0; ai < 2; ++ai)
#pragma unroll
            for (int m = 0; m < 4; ++m) { bf16* rp = O + (size_t)(u.pm * 256 + ai * 128 + wr * 64 + m * 16 + fr) * ldc + u.pn * 256 + wc * 32 + 8 * fq;
#pragma unroll
                for (int bj = 0; bj < 2; ++bj) *(GAS v4u*)(rp + bj * 128) = pack8(acc[ai][bj][m][0], acc[ai][bj][m][1], 1.0f); }
    }
};
struct EpiFp8 {
    static constexpr bool PERM = true;
    unsigned char* O; int ldc;
    __device__ __forceinline__ void operator()(const f32x4 (&acc)[2][2][4][2], const Unit& u, int wr, int wc, int fr, int fq) const {
#pragma unroll
        for (int ai = 0; ai < 2; ++ai)
#pragma unroll
            for (int m = 0; m < 4; ++m) { unsigned char* rp = O + (size_t)(u.pm * 256 + ai * 128 + wr * 64 + m * 16 + fr) * ldc + u.pn * 256 + wc * 32 + 8 * fq;
#pragma unroll
                for (int bj = 0; bj < 2; ++bj) { const f32x4 a = acc[ai][bj][m][0], b = acc[ai][bj][m][1]; int w0 = 0, w1 = 0;
                    w0 = __builtin_amdgcn_cvt_pk_fp8_f32(a[0], a[1], w0, false); w0 = __builtin_amdgcn_cvt_pk_fp8_f32(a[2], a[3], w0, true);
                    w1 = __builtin_amdgcn_cvt_pk_fp8_f32(b[0], b[1], w1, false); w1 = __builtin_amdgcn_cvt_pk_fp8_f32(b[2], b[3], w1, true);
                    *(GAS u32x2*)(rp + bj * 128) = (u32x2){(unsigned)w0, (unsigned)w1}; } }
    }
};
struct EpiGU {
    static constexpr bool PERM = true;
    bf16* he;
    __device__ __forceinline__ void operator()(const f32x4 (&acc)[2][2][4][2], const Unit& u, int wr, int wc, int fr, int fq) const {
#pragma unroll
        for (int ai = 0; ai < 2; ++ai)
#pragma unroll
            for (int m = 0; m < 4; ++m) { bf16* rp = he + (size_t)(u.pm * 256 + ai * 128 + wr * 64 + m * 16 + fr) * DE + u.pn * 128 + wc * 32 + 8 * fq;
                f32x4 h0, h1;
#pragma unroll
                for (int k = 0; k < 4; ++k) { h0[k] = siluf_(acc[ai][0][m][0][k]) * acc[ai][1][m][0][k]; h1[k] = siluf_(acc[ai][0][m][1][k]) * acc[ai][1][m][1][k]; }
                *(GAS v4u*)rp = pack8(h0, h1, 1.0f); }
    }
};
struct Args { const float* in[24]; float* out; unsigned char* ws; int ph_lo, ph_hi, li, pad; };
__global__ void __launch_bounds__(NWAVES * 64, 2) fwd(Args args) {
    extern __shared__ __attribute__((aligned(16))) unsigned char lds_raw[];
    LAS unsigned char* lds = (LAS unsigned char*)lds_raw;
    const int tid = threadIdx.x, lane = tid & 63, wave = __builtin_amdgcn_readfirstlane(tid >> 6);
    const int G = gridDim.x, blk = blockIdx.x;
    const int gw = blk * NWAVES + wave, ngw = G * NWAVES;
    unsigned char* ws = args.ws;
    gu32* ctl = (gu32*)(ws + WS_CTL);
    volatile LAS unsigned* MISC = (volatile LAS unsigned*)(lds + MISC_OFF);
    if (tid < 64) MISC[tid] = 0u;
    __syncthreads();
    XcdBarrier bar; bar.bar = (unsigned*)ctl + CW_BAR + args.li * XCD_BAR_WORDS; bar.x = 0; bar.st = nullptr;
    if (MK_N_LAUNCHES == 1) bar = xcd_barrier_post((unsigned*)ctl + CW_BAR + args.li * XCD_BAR_WORDS, MISC + 8);
    const int lo = args.ph_lo, hi = args.ph_hi;
#ifndef PHASE_MASK
#define PHASE_MASK 0x3ffff
#endif
#define IN(k) (((PHASE_MASK >> (k)) & 1) && lo <= (k) && (k) < hi)
#ifndef DBG_REP_MASK
#define DBG_REP_MASK 0
#endif
#define NREP(k) (1 + ((DBG_REP_MASK >> (k)) & 1) * 2)
#ifndef DBG_TIME_OFF
#define DBG_TIME_OFF 10.0f
#endif
#ifdef DBG_TIME_PHASE
    unsigned long long* tsv = (unsigned long long*)(ws + WS_CTL + 80000);
#define TS(k) do { if (blk == 0 && tid == 0) tsv[k] = __builtin_amdgcn_s_memrealtime(); } while (0)
#else
#define TS(k) do {} while (0)
#endif
#define SEAM(k) do { if (IN(k) && IN((k) + 1)) xcd_barrier(bar); TS((k) + 1); } while (0)
#define x (args.in[0])
#define c_in (args.in[1])
#define nsa_w_in (args.in[2])
#define cmp_k_w1 (args.in[3])
#define cmp_k_w2 (args.in[4])
#define cmp_v_w1 (args.in[5])
#define cmp_v_w2 (args.in[6])
#define cmp_k_pos (args.in[7])
#define cmp_v_pos (args.in[8])
#define nsa_w_out (args.in[9])
#define swa_w_q (args.in[10])
#define swa_sinks (args.in[11])
#define swa_w_out (args.in[12])
#define shared_w_kv (args.in[13])
#define rel_bias (args.in[14])
#define router_w (args.in[15])
#define router_b (args.in[16])
#define moe_w_gate (args.in[17])
#define moe_w_up (args.in[18])
#define moe_w_down (args.in[19])
#define ada_w (args.in[20])
#define ada_b (args.in[21])
#define ln_g (args.in[22])
#define ln_b (args.in[23])
#define out (args.out)
#define bufA ((bf16*)(ws + WS_A))
#define bufB ((bf16*)(ws + WS_B))
#define bufC ((bf16*)(ws + WS_C))
#define bufD ((bf16*)(ws + WS_D))
#define bufE ((bf16*)(ws + WS_E))
#define cnt0 ((unsigned*)ctl + CW_CNT0)
#define cnt1 ((unsigned*)ctl + CW_CNT1)
#define list ((const unsigned*)(ws + WS_LIST))
#define tokw ((const float*)(ws + WS_TOKW))

    TS(0);
    if (IN(0)) {
        P0Args a{c_in, nsa_w_in, cmp_k_w1, cmp_v_w1, cmp_k_pos, cmp_v_pos, nsa_w_out, swa_w_q, shared_w_kv, swa_w_out, moe_w_gate, moe_w_up, moe_w_down, ada_w, ada_b, ws};
        p0_small(a, lds, blk, G, tid);
        p0_transposes(a, lds, gw, ngw, wave, lane);
        if (blk >= G - 4) att::build_tb_global((unsigned short*)(ws + WS_TBL) + (blk - (G - 4)) * (4 * att::TSZ), rel_bias, blk - (G - 4), 512, tid);
    }
    SEAM(0);
    if (IN(1)) for (int rep = 0; rep < NREP(1); ++rep) p_modulate(x, ws, 0, bufA, gw, ngw, lane);
    SEAM(1);
    if (IN(2)) for (int rep = 0; rep < NREP(2); ++rep) {
        pg8::Gemm g{bufA, (const bf16*)(ws + WS_WIN), DM, DM}; SchedPlain S; S.go.init(NT / 256, 10, G, blk); S.arow_off = 0;
        EpiProj E{bufB, bufC, (float*)(ws + WS_GATE)};
        pg8::gemm_phase(lds + RING_OFF, g, S, E);
    }
    SEAM(2);
    if (IN(3)) for (int rep = 0; rep < NREP(3); ++rep) {
        pg8::Gemm g{bufA, (const bf16*)(ws + WS_WIN), DM, DM}; SchedCmpGate S{G, blk, (int)((WS_C - WS_A) / (DM * 2)), (int)((WS_CW1 - WS_WIN) / (DM * 2))};
        EpiCmpGate E{(float*)(ws + WS_UL), (float*)(ws + WS_GATE)};
        pg8::gemm_phase(lds + RING_OFF, g, S, E);
    }
    SEAM(3);
    if (IN(4)) for (int rep = 0; rep < NREP(4); ++rep) p_cmp_tail(cmp_k_w2, cmp_v_w2, ws, lds, blk, G, tid);
    SEAM(4);
    if (IN(5)) {
        { att::NsaArgs A{bufB, bufC, (const bf16*)(ws + WS_KCMP), (const bf16*)(ws + WS_VCMP), (const float*)(ws + WS_GATE), rel_bias, bufA, (unsigned*)ctl + 64 + 64 * args.li, ws + WS_TBL};
          att::nsa_phase<0>(A, lds, (unsigned)(uintptr_t)lds_raw, tid); }
    }
    SEAM(5);
    if (IN(6)) for (int rep = 0; rep < NREP(6); ++rep) {
        pg8::Gemm g{bufA, (const bf16*)(ws + WS_WOUT0), DM, DM}; SchedPlain S; S.go.init(NT / 256, 4, G, blk); S.arow_off = 0;
        EpiBf16 E{bufB, DM};
        pg8::gemm_phase(lds + RING_OFF, g, S, E);
    }
    SEAM(6);
    if (IN(7)) { LnRouterArgs a{x, nullptr, bufB, bufE, bufA, ln_g, ln_b, router_w, router_b, ws, 0, cnt0}; p_ln_router<false>(a, lds, blk, G, tid); }
    SEAM(7);
    if (IN(8)) for (int rep = 0; rep < NREP(8); ++rep) {
        pg8::Gemm g{bufA, (const bf16*)(ws + WS_WGU), DM, DM}; SchedMoe<2, true, 512> S; S.init(cnt0, list, G, blk, MISC + 16, 0, 2);
        EpiGU E{bufD};
        pg8::gemm_phase(lds + RING_OFF, g, S, E);
    }
    SEAM(8);
    if (IN(9)) for (int rep = 0; rep < NREP(9); ++rep) {
        { pg8::Gemm g{bufA, (const bf16*)(ws + WS_WGU), DM, DM}; SchedMoe<2, true, 512> S; S.init(cnt0, list, G, blk, MISC + 16, 2);
          EpiGU E{bufD};
          const bool producer = 2 * G + blk < 2 * (int)MISC[16 + 32];
          pg8::gemm_phase(lds + RING_OFF, g, S, E);
          if (producer && tid == 0) { __builtin_amdgcn_fence(__ATOMIC_RELEASE, "agent"); asm volatile("s_waitcnt vmcnt(0)" ::: "memory");
              (void)__hip_atomic_fetch_add((unsigned*)ctl + CW_DEP0, 1u, __ATOMIC_RELAXED, __HIP_MEMORY_SCOPE_AGENT); } }
        pg8::Gemm g{bufD, (const bf16*)(ws + WS_WD), DE, DE}; SchedMoeLate<4, 1024> S; S.init(cnt0, G, blk, MISC + 16, (const unsigned*)ctl + CW_DEP0);
        EpiFp8 E{(unsigned char*)bufC, DM};
        pg8::gemm_phase(lds + RING_OFF, g, S, E);
    }
    SEAM(9);
    if (IN(10)) p_ln_ffn<false>(nullptr, bufE, nullptr, bufB, (const unsigned char*)bufC, ln_g, ln_b, ln_g + DM, ln_b + DM, ws, 0, bufD, bufA, cnt0, lds, gw, ngw, tid);
    SEAM(10);
    if (IN(11)) for (int rep = 0; rep < NREP(11); ++rep) {
        pg8::Gemm g{bufA, (const bf16*)(ws + WS_WQ1), DM, DM}; SchedL1 S; S.go.init(NT / 256, 6, G, blk); S.xb_rowoff = (int)((WS_D - WS_A) / (DM * 2));
        EpiL1 E{bufB, bufC};
        pg8::gemm_phase(lds + RING_OFF, g, S, E);
    }
    SEAM(11);
    if (IN(12)) for (int rep = 0; rep < NREP(12); ++rep) {
        att::SwaArgs A{bufB, bufC, swa_sinks, rel_bias, bufA};
        att::swa_phase(A, lds, (unsigned)(uintptr_t)lds_raw, blk, G, tid);
    }
    SEAM(12);
    if (IN(13)) {
        pg8::Gemm g{bufA, (const bf16*)(ws + WS_WOUT1), DM, DM}; SchedPlain S; S.go.init(NT / 256, 4, G, blk); S.arow_off = 0;
        EpiBf16 E{bufB, DM};
        pg8::gemm_phase(lds + RING_OFF, g, S, E);
    }
    SEAM(13);
    if (IN(14)) { LnRouterArgs a{nullptr, bufD, bufB, bufD, bufA, ln_g + 2 * DM, ln_b + 2 * DM, router_w, router_b, ws, 1, cnt1}; p_ln_router<true>(a, lds, blk, G, tid); }
    SEAM(14);
    if (IN(15)) {
        pg8::Gemm g{bufA, (const bf16*)(ws + WS_WGU) + (size_t)NE * 512 * DM, DM, DM}; SchedMoe<2, true, 512> S; S.init(cnt1, list, G, blk, MISC + 16, 0, 2);
        EpiGU E{bufE};
        pg8::gemm_phase(lds + RING_OFF, g, S, E);
    }
    SEAM(15);
    if (IN(16)) {
        { pg8::Gemm g{bufA, (const bf16*)(ws + WS_WGU) + (size_t)NE * 512 * DM, DM, DM}; SchedMoe<2, true, 512> S; S.init(cnt1, list, G, blk, MISC + 16, 2);
          EpiGU E{bufE};
          const bool producer = 2 * G + blk < 2 * (int)MISC[16 + 32];
          pg8::gemm_phase(lds + RING_OFF, g, S, E);
          if (producer && tid == 0) { __builtin_amdgcn_fence(__ATOMIC_RELEASE, "agent"); asm volatile("s_waitcnt vmcnt(0)" ::: "memory");
              (void)__hip_atomic_fetch_add((unsigned*)ctl + CW_DEP1, 1u, __ATOMIC_RELAXED, __HIP_MEMORY_SCOPE_AGENT); } }
        pg8::Gemm g{bufE, (const bf16*)(ws + WS_WD) + (size_t)NE * DM * DE, DE, DE}; SchedMoeLate<4, 1024> S; S.init(cnt1, G, blk, MISC + 16, (const unsigned*)ctl + CW_DEP1);
        EpiFp8 E{(unsigned char*)bufC, DM};
        pg8::gemm_phase(lds + RING_OFF, g, S, E);
    }
    SEAM(16);
    if (IN(17)) p_ln_ffn<true>(nullptr, bufD, out, bufB, (const unsigned char*)bufC, ln_g + 2 * DM, ln_b + 2 * DM, ln_g + 3 * DM, ln_b + 3 * DM, ws, 1, nullptr, nullptr, cnt1, lds, gw, ngw, tid);
#undef IN
#undef SEAM
#undef x
#undef c_in
#undef out
#undef list
#undef tokw
#undef bufA
#undef bufB
#undef bufC
#undef bufD
#undef bufE
#undef cnt0
#undef cnt1
#undef ln_g
#undef ln_b
#undef rel_bias
#undef router_w
#undef router_b
}

#ifdef DBG_NSA_VAR
__global__ void __launch_bounds__(NWAVES * 64, 2) nsa_probe(Args args) {
    extern __shared__ __attribute__((aligned(16))) unsigned char lds_raw[];
    LAS unsigned char* lds = (LAS unsigned char*)lds_raw;
    unsigned char* ws = args.ws; gu32* ctl = (gu32*)(ws + WS_CTL);
    att::NsaArgs A{(const bf16*)(ws + WS_B), (const bf16*)(ws + WS_C), (const bf16*)(ws + WS_KCMP), (const bf16*)(ws + WS_VCMP), (const float*)(ws + WS_GATE), args.in[14], (bf16*)(ws + WS_D), (unsigned*)ctl + 128, ws + WS_TBL};
    att::nsa_phase<DBG_NSA_VAR>(A, lds, (unsigned)(uintptr_t)lds_raw, (int)threadIdx.x);
}
#endif
extern "C" void kernel_launch(void* const* d_in, const int* in_sizes, int n_in, void* d_out, int out_size, void* d_ws, size_t ws_size, hipStream_t stream) {
    static int grid = 0;
    if (grid == 0) {
        if (n_in != 24 || in_sizes[0] != NT * DM || out_size != NT * DM || ws_size < WS_END) { fprintf(stderr, "kernel_launch: unexpected shapes (n_in %d, in0 %d, out %d, ws %zu); nothing launched\n", n_in, n_in > 0 ? in_sizes[0] : -1, out_size, ws_size); grid = -1; return; }
        int dev = 0, cus = 0, per_cu = 0;
        if (hipGetDevice(&dev) != hipSuccess || hipDeviceGetAttribute(&cus, hipDeviceAttributeMultiprocessorCount, dev) != hipSuccess) { grid = -1; return; }
        if (hipFuncSetAttribute((const void*)fwd, hipFuncAttributeMaxDynamicSharedMemorySize, LDS_BYTES) != hipSuccess) { fprintf(stderr, "kernel_launch: hipFuncSetAttribute failed\n"); grid = -1; return; }
        if (hipOccupancyMaxActiveBlocksPerMultiprocessor(&per_cu, (const void*)fwd, NWAVES * 64, LDS_BYTES) != hipSuccess || per_cu < 1) fprintf(stderr, "kernel_launch: occupancy query reports %d\n", per_cu);
        (void)hipGetLastError();
        grid = cus;
        if (grid != 256) { fprintf(stderr, "kernel_launch: built for a 256-CU device, found %d CUs; nothing launched\n", cus); grid = -1; return; }
    }
    if (grid < 0) return;
    if (hipMemsetAsync((char*)d_ws + WS_CTL, 0, CTL_ZERO_BYTES, stream) != hipSuccess) return;
    Args a{};
    for (int i = 0; i < 24; ++i) a.in[i] = (const float*)d_in[i];
    a.out = (float*)d_out; a.ws = (unsigned char*)d_ws;
#if defined(DBG_REDO_PHASE)
    a.ph_lo = 0; a.ph_hi = DBG_REDO_PHASE + 1; a.li = 0; hipLaunchKernelGGL(fwd, dim3(grid), dim3(NWAVES * 64), LDS_BYTES, stream, a);
    a.ph_lo = DBG_REDO_PHASE; a.ph_hi = DBG_REDO_PHASE + 1; a.li = 1; hipLaunchKernelGGL(fwd, dim3(grid), dim3(NWAVES * 64), LDS_BYTES, stream, a);
    a.ph_lo = DBG_REDO_PHASE + 1; a.ph_hi = N_PHASES; a.li = 2; hipLaunchKernelGGL(fwd, dim3(grid), dim3(NWAVES * 64), LDS_BYTES, stream, a);
#elif defined(DBG_NSA_VAR)
    (void)hipFuncSetAttribute((const void*)nsa_probe, hipFuncAttributeMaxDynamicSharedMemorySize, LDS_BYTES);
    a.ph_lo = 0; a.ph_hi = 6; a.li = 0; hipLaunchKernelGGL(fwd, dim3(grid), dim3(NWAVES * 64), LDS_BYTES, stream, a);
    hipLaunchKernelGGL(nsa_probe, dim3(grid), dim3(NWAVES * 64), LDS_BYTES, stream, a);
    a.ph_lo = 6; a.ph_hi = N_PHASES; a.li = 1; hipLaunchKernelGGL(fwd, dim3(grid), dim3(NWAVES * 64), LDS_BYTES, stream, a);
#elif MK_N_LAUNCHES == 1
    a.ph_lo = 0; a.ph_hi = N_PHASES;
    hipLaunchKernelGGL(fwd, dim3(grid), dim3(NWAVES * 64), LDS_BYTES, stream, a);
#else
    for (int p = 0; p < N_PHASES; ++p) { a.ph_lo = p; a.ph_hi = p + 1; hipLaunchKernelGGL(fwd, dim3(grid), dim3(NWAVES * 64), LDS_BYTES, stream, a); }
#endif
}
```
